# Optimizing an MI355X kernel written in HIP

```python
import jax, jax.numpy as jnp
from jax import lax
import numpy as np

D_MODEL = 1024
BATCH = 8
SEQ = 2048
DEPTH = 1
DEC_BATCH = 128
DEC_SEQ = 4
PAST_LEN = 16384
PAGE_SIZE = 128

W_A = D_MODEL // 2
HGRN_EXPAND = 128
H_A = W_A // HGRN_EXPAND
DK = HGRN_EXPAND
DV = W_A // H_A
CHUNK = 32
W_B = D_MODEL // 2
POOL_WINDOWS = (2, 4, 8, 16)
N_POOL_GROUPS = len(POOL_WINDOWS)
G_B = W_B // N_POOL_GROUPS
POOL_BUF = max(POOL_WINDOWS) - 1
D_IN = 4 * W_A + 2 * W_B + 2 * D_MODEL
EPS = 1e-6

kernel_name = 'hgrn2_pool_gated_hybrid_step'


def _rmsnorm(x, g):
    x32 = x.astype(jnp.float32)
    y = x32 * lax.rsqrt(jnp.mean(x32 * x32, axis=-1, keepdims=True) + EPS)
    return (y * g.astype(jnp.float32)).astype(x.dtype)


def _hgrn2_chunked(q, k, v, logf, s0):
    B, T, H, _ = q.shape
    C = CHUNK if T >= CHUNK else T
    n = -(-T // C)
    pad = n * C - T

    def to_chunks(a):
        a = jnp.pad(a, ((0, 0), (0, pad), (0, 0), (0, 0)))
        return a.reshape(B, n, C, H, a.shape[-1]).transpose(1, 0, 3, 2, 4)

    qc, kc, vc, gc = to_chunks(q), to_chunks(k), to_chunks(v), to_chunks(logf)
    causal = jnp.tril(jnp.ones((C, C), dtype=bool))

    def step(S, blk):
        qb, kb, vb, gb = blk
        b = jnp.cumsum(gb, axis=2)
        ref = b[:, :, C // 2:C // 2 + 1]
        b_last = b[:, :, C - 1:C]
        scores = jnp.einsum('bhtd,bhsd->bhts', qb * jnp.exp(b - ref), kb * jnp.exp(ref - b))
        scores = jnp.where(causal, scores, 0.0)
        o = (jnp.einsum('bhts,bhsv->bhtv', scores, vb)
             + jnp.einsum('bhtd,bhdv->bhtv', qb * jnp.exp(b), S))
        S = (jnp.exp(b_last[:, :, 0])[..., None] * S
             + jnp.einsum('bhsd,bhsv->bhdv', kb * jnp.exp(b_last - b), vb))
        return S, o

    S, o = lax.scan(step, s0, (qc, kc, vc, gc))
    o = o.transpose(1, 0, 3, 2, 4).reshape(B, n * C, H, -1)[:, :T]
    return o, S


def _multiscale_pool(u, buf, pos0):
    B, T, _ = u.shape
    u32 = u.astype(jnp.float32)
    ext = jnp.concatenate([buf.astype(jnp.float32), u32], axis=1)
    cs = jnp.concatenate([jnp.zeros((B, 1, W_B), jnp.float32), jnp.cumsum(ext, axis=1)], axis=1)
    pos = pos0 + jnp.arange(T)
    outs = []
    for gi, w in enumerate(POOL_WINDOWS):
        lo, hi = gi * G_B, (gi + 1) * G_B
        s = cs[:, POOL_BUF + 1:POOL_BUF + 1 + T, lo:hi] - cs[:, POOL_BUF + 1 - w:POOL_BUF + 1 - w + T, lo:hi]
        cnt = jnp.minimum(pos + 1, w).astype(jnp.float32)
        outs.append(s / cnt[None, :, None])
    return jnp.concatenate(outs, axis=-1) - u32


def _layer(x, s0, buf0, pos0, lb, norm_g, w_in, hgrn_norm_g, w_proj_a, w_pool, pool_scale, w_proj_b, w_out):
    B, T, _ = x.shape
    dt = x.dtype
    h = _rmsnorm(x, norm_g)
    z = h @ w_in
    q, f, i, g_a, u, g_b, m_a, m_b = jnp.split(
        z, np.cumsum([W_A, W_A, W_A, W_A, W_B, W_B, D_MODEL]).tolist(), axis=-1)
    fgate = lb + (1.0 - lb) * jax.nn.sigmoid(f.astype(jnp.float32))
    logf = jnp.log(fgate)
    kin = 1.0 - fgate
    qf = jax.nn.silu(q.astype(jnp.float32)) * (DK ** -0.5)
    hd = lambda a: a.reshape(B, T, H_A, -1)
    o, s_new = _hgrn2_chunked(hd(qf), hd(kin), hd(i.astype(jnp.float32)), hd(logf), s0)
    o = _rmsnorm(o, hgrn_norm_g) * jax.nn.silu(hd(g_a.astype(jnp.float32)))
    y_a = o.reshape(B, T, W_A).astype(dt) @ w_proj_a
    pooled = _multiscale_pool(u, buf0, pos0).reshape(B, T, N_POOL_GROUPS, G_B)
    mixed = jnp.einsum('btgc,gcd->btgd', pooled, w_pool.astype(jnp.float32)).reshape(B, T, W_B)
    yb = mixed * pool_scale.astype(jnp.float32) * jax.nn.silu(g_b.astype(jnp.float32))
    y_b = yb.astype(dt) @ w_proj_b
    merged = jax.nn.sigmoid(m_a) * y_a + jax.nn.sigmoid(m_b) * y_b
    out = x + merged @ w_out
    new_buf = jnp.concatenate([buf0.astype(dt), u], axis=1)[:, -POOL_BUF:]
    return out, s_new, new_buf


def setup_inputs(seed: int = 0) -> dict:
    key = jax.random.key(seed)
    ks = jax.random.split(key, 14)
    nrm = lambda k, s: jax.random.normal(k, s, jnp.float32)
    return {
        'x_prompt': nrm(ks[0], (BATCH, SEQ, D_MODEL)),
        'x_sample': nrm(ks[1], (DEC_BATCH, DEC_SEQ, D_MODEL)),
        'state_hgrn': 0.5 * nrm(ks[2], (DEPTH, DEC_BATCH, H_A, DK, DV)),
        'state_pool': nrm(ks[3], (DEPTH, DEC_BATCH, POOL_BUF, W_B)),
        'norm_g': 1.0 + 0.02 * nrm(ks[4], (DEPTH, D_MODEL)),
        'w_in': nrm(ks[5], (DEPTH, D_MODEL, D_IN)) * D_MODEL ** -0.5,
        'lb_logits': 0.1 * nrm(ks[6], (DEPTH + 1, W_A)),
        'hgrn_norm_g': 1.0 + 0.02 * nrm(ks[7], (DEPTH, DV)),
        'w_proj_a': nrm(ks[8], (DEPTH, W_A, D_MODEL)) * W_A ** -0.5,
        'w_pool': nrm(ks[9], (DEPTH, N_POOL_GROUPS, G_B, G_B)) * G_B ** -0.5,
        'pool_scale': 1.0 + 0.1 * nrm(ks[10], (DEPTH, W_B)),
        'w_proj_b': nrm(ks[11], (DEPTH, W_B, D_MODEL)) * W_B ** -0.5,
        'w_out': nrm(ks[12], (DEPTH, D_MODEL, D_MODEL)) * D_MODEL ** -0.5,
        'final_norm_g': 1.0 + 0.02 * nrm(ks[13], (D_MODEL,)),
    }


def reference(x_prompt, x_sample, state_hgrn, state_pool, norm_g, w_in, lb_logits, hgrn_norm_g,
              w_proj_a, w_pool, pool_scale, w_proj_b, w_out, final_norm_g):
    lbs = jnp.cumsum(jax.nn.softmax(lb_logits.astype(jnp.float32), axis=0), axis=0)
    yp, ys = x_prompt, x_sample
    hp, pp, hs, ps = [], [], [], []
    for l in range(DEPTH):
        s0p = jnp.zeros((BATCH, H_A, DK, DV), jnp.float32)
        b0p = jnp.zeros((BATCH, POOL_BUF, W_B), x_prompt.dtype)
        yp, s_p, b_p = _layer(yp, s0p, b0p, 0, lbs[l], norm_g[l], w_in[l], hgrn_norm_g[l],
                              w_proj_a[l], w_pool[l], pool_scale[l], w_proj_b[l], w_out[l])
        ys, s_s, b_s = _layer(ys, state_hgrn[l].astype(jnp.float32), state_pool[l], PAST_LEN, lbs[l],
                              norm_g[l], w_in[l], hgrn_norm_g[l], w_proj_a[l], w_pool[l],
                              pool_scale[l], w_proj_b[l], w_out[l])
        hp.append(s_p.astype(state_hgrn.dtype)); pp.append(b_p.astype(state_pool.dtype))
        hs.append(s_s.astype(state_hgrn.dtype)); ps.append(b_s.astype(state_pool.dtype))
    y_prompt = _rmsnorm(yp, final_norm_g)
    y_sample = _rmsnorm(ys, final_norm_g)
    return (y_prompt, y_sample, jnp.stack(hp), jnp.stack(pp), jnp.stack(hs), jnp.stack(ps))
```

```cpp
#include <hip/hip_runtime.h>
#include <cstdio>
#include <cstdint>

#ifndef MK_N_LAUNCHES
#define MK_N_LAUNCHES 1
#endif

namespace pg8 {
#define PG8_LAS __attribute__((address_space(3)))
typedef unsigned short bf16_t;
typedef short bf16x8 __attribute__((ext_vector_type(8)));
typedef float f32x4 __attribute__((ext_vector_type(4)));
typedef unsigned u32x4 __attribute__((ext_vector_type(4)));
constexpr int BM = 256, BK = 64, HALF = 128, HTB = HALF * BK * 2  , STAGE_BYTES = 8 * HTB, NXCD = 8, WGM = 8;

__host__ __device__ __forceinline__ int lds_byte(int r, int c) { const int st = (r >> 4) * 2 + (c >> 5), rr = r & 15, cc = c & 31, ob = rr * 64 + cc * 2; return st * 1024 + (ob ^ (((ob >> 9) & 1) << 5)); }
__host__ __device__ __forceinline__ void stage_rc(int b, int& R, int& C) { const int st = b / 1024, sb = b % 1024, swz = sb ^ (((sb >> 9) & 1) << 5); R = (st >> 1) * 16 + swz / 64; C = (st & 1) * 32 + (swz % 64) / 2; }
__host__ __device__ __forceinline__ int perm32(int rho) { const int n = rho >> 4, i = rho & 15; return 8 * (i >> 2) + 4 * n + (i & 3); }

struct Unit { int pm, pn, kind, half, r0; };

struct TileOrder {
    int nM, nN, nwg, G, c;
    __host__ __device__ void init(int M, int N, int G_, int c_) { nM = M / BM; nN = N / BM; nwg = nM * nN; G = G_; c = c_; }
    __host__ __device__ bool tile(long L, int& pm, int& pn) const {
        if (L >= nwg) return false;
        int wgid = (int)L; { const int q = nwg / NXCD, r = nwg % NXCD, xcd = wgid % NXCD, off = wgid / NXCD; wgid = (xcd < r ? xcd * (q + 1) : r * (q + 1) + (xcd - r) * q) + off; }
        const int nig = WGM * nN, gid = wgid / nig, fm = gid * WGM, gsz = (nM - fm) < WGM ? (nM - fm) : WGM;
        pm = fm + ((wgid % nig) % gsz); pn = (wgid % nig) / gsz; return true;
    }
};
struct OrderSingle : TileOrder {
    const char* A; const char* Bt; size_t tstep;
    int split;
    __device__ __forceinline__ bool next(int i, Unit& u) const { u.kind = 0; u.half = 0;
        if (split && i >= nwg / G) { if (i > nwg / G || c >= 2 * (nwg % G)) return false;
            const int xcd = c % NXCD, j = c / NXCD, wl = (nwg / NXCD) * xcd + (nwg / NXCD - (nwg % G) / NXCD) + (j >> 1);
            const int nig = WGM * nN, gid = wl / nig, fm = gid * WGM, gsz = (nM - fm) < WGM ? (nM - fm) : WGM;
            u.pm = fm + ((wl % nig) % gsz); u.pn = (wl % nig) / gsz; u.half = 1; u.r0 = u.pm * BM + (j & 1) * HALF; return true; }
        const bool ok = tile((long)i * G + c, u.pm, u.pn); u.r0 = u.pm * BM; return ok; }
    __device__ __forceinline__ const char* opA(const Unit& u) const { return A + (size_t)u.r0 * (tstep / BM); }
    __device__ __forceinline__ const char* opB(const Unit& u) const { return Bt + (size_t)u.pn * tstep; }
    int ntiles;
    __device__ __forceinline__ int nt(const Unit&) const { return ntiles; }
    __device__ __forceinline__ void done(const Unit&, int) const {}
};
__device__ __forceinline__ unsigned cvt_pk_bf16(float lo, float hi) { unsigned r; asm volatile("v_cvt_pk_bf16_f32 %0, %1, %2" : "=v"(r) : "v"(lo), "v"(hi)); return r; }

template <class Epi, class Sched, bool ALIGN_EPI = false, bool SP2 = false>
__device__ __forceinline__ void gemm_phase(PG8_LAS unsigned char* lds, const int K, const Sched& S, const Epi& E) {
    int tid = threadIdx.x; asm volatile("" : "+v"(tid));
    const int wid = __builtin_amdgcn_readfirstlane(tid >> 6), lane = tid & 63, wr = wid >> 2, wc = wid & 3, fr = lane & 15, fq = lane >> 4;
    unsigned voffA[2], voffB[2];
#pragma unroll
    for (int i = 0; i < 2; ++i) { int R, C; stage_rc(tid * 16 + i * 8192, R, C); const int Rb = Epi::PERM ? ((R & ~31) + perm32(R & 31)) : R;
        voffA[i] = (unsigned)(R * K + C) * 2u; voffB[i] = (unsigned)(Rb * K + C) * 2u; }
    const size_t kstep = (size_t)(BK * 2);
    const size_t hstep = (size_t)HALF * K * 2;
    const unsigned ldsw = (unsigned)wid * 1024u;
    const int aoff = lds_byte(wr * 64 + fr, fq * 8), boff = lds_byte(wc * 32 + fr, fq * 8);
#define PG8_SA(b, h) (((b) * 2 + (h)) * HTB)
#define PG8_SB(b, h) ((4 + (b) * 2 + (h)) * HTB)
#define PG8_STAGE(bufoff, gbase, voff) do { _Pragma("unroll") for (int _i = 0; _i < 2; ++_i) \
        __builtin_amdgcn_global_load_lds((const unsigned*)((const char*)(gbase) + (voff)[_i]), (PG8_LAS unsigned*)(lds + (bufoff) + ldsw + _i * 8192), 16, 0, 0); } while (0)
#define PG8_LDA(dst, b, h) do { _Pragma("unroll") for (int m = 0; m < 4; ++m) _Pragma("unroll") for (int k = 0; k < 2; ++k) dst[m][k] = *(const PG8_LAS bf16x8*)(lds + PG8_SA(b, h) + aoff + m * 2048 + k * 1024); } while (0)
#define PG8_LDB(dst, b, h) do { _Pragma("unroll") for (int n = 0; n < 2; ++n) _Pragma("unroll") for (int k = 0; k < 2; ++k) dst[n][k] = *(const PG8_LAS bf16x8*)(lds + PG8_SB(b, h) + boff + n * 2048 + k * 1024); } while (0)
#define PG8_MMA(ai, bj, At, Bt) do { __builtin_amdgcn_s_setprio(1); _Pragma("unroll") for (int m = 0; m < 4; ++m) _Pragma("unroll") for (int n = 0; n < 2; ++n) _Pragma("unroll") for (int k = 0; k < 2; ++k) \
        acc[ai][bj][m][n] = __builtin_amdgcn_mfma_f32_16x16x32_bf16(Bt[n][k], At[m][k], acc[ai][bj][m][n], 0, 0, 0); __builtin_amdgcn_s_setprio(0); } while (0)
#define PG8_WAIT_V(n) asm volatile("s_waitcnt vmcnt(" #n ")" ::: "memory")
#define PG8_WAIT_L(n) asm volatile("s_waitcnt lgkmcnt(" #n ")" ::: "memory")
#define PG8_BAR __builtin_amdgcn_s_barrier()
#define PG8_SCHED __builtin_amdgcn_sched_barrier(0)
    Unit cur, nxt; int ui = 0;
    if (!S.next(0, cur)) return;
    f32x4 acc[2][2][4][2];
#pragma unroll
    for (int a = 0; a < 2; ++a)
#pragma unroll
        for (int b = 0; b < 2; ++b)
#pragma unroll
            for (int m = 0; m < 4; ++m)
#pragma unroll
                for (int n = 0; n < 2; ++n) acc[a][b][m][n] = (f32x4){0.f, 0.f, 0.f, 0.f};
    bf16x8 At[4][2], B0[2][2], B1[2][2];
    const char* cA = S.opA(cur); const char* cB = S.opB(cur);
    size_t chA = cur.half ? 0 : hstep;
    if constexpr (SP2) {
        PG8_STAGE(PG8_SB(0, 0), cB, voffB); PG8_STAGE(PG8_SB(0, 1), cB + hstep, voffB); PG8_STAGE(PG8_SA(0, 0), cA, voffA); PG8_STAGE(PG8_SA(0, 1), cA + chA, voffA);
        if (wr == 1) PG8_BAR;
        PG8_WAIT_V(2); PG8_BAR;
        PG8_STAGE(PG8_SB(1, 0), cB + kstep, voffB); PG8_STAGE(PG8_SA(1, 0), cA + kstep, voffA); PG8_STAGE(PG8_SB(1, 1), cB + hstep + kstep, voffB);
        PG8_WAIT_V(6); PG8_BAR;
    } else {
        PG8_STAGE(PG8_SB(0, 0), cB, voffB); PG8_STAGE(PG8_SA(0, 0), cA, voffA); PG8_STAGE(PG8_SB(0, 1), cB + hstep, voffB); PG8_STAGE(PG8_SA(0, 1), cA + chA, voffA);
        if (wr == 1) PG8_BAR;
        PG8_WAIT_V(4); PG8_BAR;
        PG8_STAGE(PG8_SB(1, 0), cB + kstep, voffB); PG8_STAGE(PG8_SA(1, 0), cA + kstep, voffA); PG8_STAGE(PG8_SB(1, 1), cB + hstep + kstep, voffB);
        PG8_WAIT_V(6); PG8_BAR;
    }
    for (;;) {
        const bool has_next = S.next(ui + 1, nxt);
        const char* nA = has_next ? S.opA(nxt) : cA; const char* nB = has_next ? S.opB(nxt) : cB;
        const size_t nhA = has_next ? (nxt.half ? 0 : hstep) : chA;
        const bool full = cur.half == 0;
        const int nt = S.nt(cur);
        for (int t = 0; t < nt; t += 2) {
            if constexpr (Epi::HAS_MID) { if (t == S.mid_at(cur)) E.mid(acc, cur, wr, wc, fr, fq); }
            const bool last = (t == nt - 2);
            const char* a1 = cA + (size_t)(t + 1) * kstep;
            const char* a2 = last ? nA : cA + (size_t)(t + 2) * kstep; const char* b2 = last ? nB : cB + (size_t)(t + 2) * kstep;
            const char* a3 = a2 + kstep; const char* b3 = b2 + kstep;
            const size_t h2 = last ? nhA : chA;
            if constexpr (SP2) {
            PG8_LDB(B0, 0, 0); PG8_LDB(B1, 0, 1); PG8_SCHED; PG8_LDA(At, 0, 0); PG8_STAGE(PG8_SA(1, 1), a1 + chA, voffA);
            PG8_WAIT_V(8); PG8_WAIT_L(0); PG8_BAR; PG8_MMA(0, 0, At, B0); PG8_MMA(0, 1, At, B1); PG8_BAR; PG8_SCHED;
            PG8_LDA(At, 0, 1); PG8_STAGE(PG8_SB(0, 0), b2, voffB); PG8_STAGE(PG8_SB(0, 1), b2 + hstep, voffB); PG8_STAGE(PG8_SA(0, 0), a2, voffA);
            PG8_WAIT_V(8); PG8_WAIT_L(0); PG8_BAR; if (full) { PG8_MMA(1, 0, At, B0); PG8_MMA(1, 1, At, B1); } PG8_BAR; PG8_SCHED;
            PG8_LDB(B0, 1, 0); PG8_LDB(B1, 1, 1); PG8_SCHED; PG8_LDA(At, 1, 0); PG8_STAGE(PG8_SA(0, 1), a2 + h2, voffA);
            PG8_WAIT_V(8); PG8_WAIT_L(0); PG8_BAR; PG8_MMA(0, 0, At, B0); PG8_MMA(0, 1, At, B1); PG8_BAR; PG8_SCHED;
            PG8_LDA(At, 1, 1); PG8_STAGE(PG8_SB(1, 0), b3, voffB); PG8_STAGE(PG8_SB(1, 1), b3 + hstep, voffB); PG8_STAGE(PG8_SA(1, 0), a3, voffA);
            PG8_WAIT_V(8); PG8_WAIT_L(0); PG8_BAR; if (full) { PG8_MMA(1, 0, At, B0); PG8_MMA(1, 1, At, B1); } PG8_BAR; PG8_SCHED;
            } else {
            PG8_LDB(B0, 0, 0); PG8_SCHED; PG8_LDA(At, 0, 0); PG8_STAGE(PG8_SA(1, 1), a1 + chA, voffA);
            PG8_WAIT_L(8); PG8_BAR; PG8_WAIT_L(0); PG8_MMA(0, 0, At, B0); PG8_BAR; PG8_SCHED;
            PG8_LDB(B1, 0, 1); PG8_STAGE(PG8_SB(0, 0), b2, voffB);
            PG8_BAR; PG8_WAIT_L(0); PG8_MMA(0, 1, At, B1); PG8_BAR;
            PG8_LDA(At, 0, 1); PG8_STAGE(PG8_SA(0, 0), a2, voffA);
            PG8_BAR; PG8_WAIT_L(0); if (full) PG8_MMA(1, 0, At, B0); PG8_BAR; PG8_SCHED;
            PG8_STAGE(PG8_SB(0, 1), b2 + hstep, voffB);
            PG8_WAIT_V(6); PG8_BAR; if (full) PG8_MMA(1, 1, At, B1); PG8_BAR;
            PG8_LDB(B0, 1, 0); PG8_SCHED; PG8_LDA(At, 1, 0); PG8_STAGE(PG8_SA(0, 1), a2 + h2, voffA);
            PG8_WAIT_L(8); PG8_BAR; PG8_WAIT_L(0); PG8_MMA(0, 0, At, B0); PG8_BAR; PG8_SCHED;
            PG8_LDB(B1, 1, 1); PG8_STAGE(PG8_SB(1, 0), b3, voffB);
            PG8_BAR; PG8_WAIT_L(0); PG8_MMA(0, 1, At, B1); PG8_BAR;
            PG8_LDA(At, 1, 1); PG8_STAGE(PG8_SA(1, 0), a3, voffA);
            PG8_BAR; PG8_WAIT_L(0); if (full) PG8_MMA(1, 0, At, B0); PG8_BAR; PG8_SCHED;
            PG8_STAGE(PG8_SB(1, 1), b3 + hstep, voffB);
            PG8_WAIT_V(6); PG8_BAR; if (full) PG8_MMA(1, 1, At, B1); PG8_BAR;
            }
        }
        if constexpr (ALIGN_EPI) { if (wr == 0) PG8_BAR; }
        E(acc, cur, wr, wc, fr, fq, wid, lane); S.done(cur, lane);
        if (!has_next) break;
#pragma unroll
        for (int a = 0; a < 2; ++a)
#pragma unroll
            for (int b = 0; b < 2; ++b)
#pragma unroll
                for (int m = 0; m < 4; ++m)
#pragma unroll
                    for (int n = 0; n < 2; ++n) acc[a][b][m][n] = (f32x4){0.f, 0.f, 0.f, 0.f};
        cur = nxt; cA = nA; cB = nB; chA = nhA; ++ui;
        if constexpr (ALIGN_EPI) { if (wr == 1) PG8_BAR; }
    }
    PG8_WAIT_V(0);
    if constexpr (!ALIGN_EPI) { if (wr == 0) PG8_BAR; }
    PG8_BAR;
#undef PG8_SA
#undef PG8_SB
#undef PG8_STAGE
#undef PG8_LDA
#undef PG8_LDB
#undef PG8_MMA
#undef PG8_WAIT_V
#undef PG8_WAIT_L
#undef PG8_BAR
#undef PG8_SCHED
}
}

#ifndef PG8_SP2
#define PG8_SP2 true
#endif
#ifndef PG8_ALIGN
#define PG8_ALIGN true
#endif

constexpr int NWAVES = 8;
constexpr int N_LAUNCHES = MK_N_LAUNCHES;
constexpr int PER_PHASE = 6;
constexpr int D = 1024, NB = 8, T = 2048, DB = 128, DT = 4, WA = 512, NH = 4, DK = 128, DV = 128, WB = 512, PB = 15, DIN = 5120;
constexpr int MP = NB * T, MS = DB * DT, M = MP + MS;
constexpr float EPS = 1e-6f;
constexpr int CH = 32;
constexpr int SCH = 8;
constexpr int NSUP = T / (CH * SCH);
static_assert(M % 256 == 0 && NSUP == 8, "shapes");
constexpr size_t O_YP = 0, O_YS = (size_t)MP * D, O_SHP = O_YS + (size_t)MS * D, O_SPP = O_SHP + (size_t)NB * NH * DK * DV,
                 O_SHS = O_SPP + (size_t)NB * PB * WB, O_SPS = O_SHS + (size_t)DB * NH * DK * DV, O_END = O_SPS + (size_t)DB * PB * WB;
static_assert(O_END == 27258880, "output size");

constexpr size_t MiB = 1u << 20;
constexpr size_t al1(size_t x) { return (x + MiB - 1) & ~(MiB - 1); }
constexpr size_t SZ_H = (size_t)M * 512 * 2, SZ_F = (size_t)M * 1024 * 2;
constexpr size_t WS_CTL = 0, CTL_ZERO_BYTES = 192 * 1024;
constexpr size_t WS_WIN = 2 * MiB;
constexpr size_t WS_WA = WS_WIN + 10 * MiB, WS_WOUT = WS_WA + 2 * MiB, WS_WP = WS_WOUT + 2 * MiB;
constexpr size_t WS_PART = WS_WP + MiB;
constexpr size_t WS_DTOT = WS_PART + 2 * MiB;
constexpr size_t WS_XN = WS_DTOT + MiB;
constexpr size_t WS_QF = WS_XN + al1(SZ_F);
constexpr size_t WS_LOGF = WS_QF + al1(SZ_H);
constexpr size_t WS_V = WS_LOGF + al1(SZ_H);
constexpr size_t WS_GA = WS_V + al1(SZ_H);
constexpr size_t WS_U = WS_GA + al1(SZ_H);
constexpr size_t WS_GB = WS_U + al1(SZ_H);
constexpr size_t WS_MA = WS_GB + al1(SZ_H);
constexpr size_t WS_MB = WS_MA + al1(SZ_F);
constexpr size_t WS_OY = WS_MB + al1(SZ_F);
constexpr size_t WS_MG = WS_OY + al1(SZ_F);
constexpr size_t UWS_ITEM = (size_t)DK * DV;
constexpr size_t WS_UWS = WS_MG + al1(SZ_F);
constexpr size_t WS_SUF = WS_UWS + (size_t)NB * NH * NSUP * UWS_ITEM * 4;
constexpr size_t WS_END = WS_SUF + MiB;
constexpr int CW_TMO = 0, CW_CODE = 1;
constexpr int CW_BAR = 4096;
constexpr int CW_CNT1 = 16384, CW_CNT2 = 16384 + 8192;
static_assert((CW_CNT2 + 8192) * 4 <= (int)CTL_ZERO_BYTES && (CW_BAR + 3456) * 4 <= (int)CTL_ZERO_BYTES, "control words inside the zeroed region");

constexpr int RING_OFF = 0, RING_BYTES = 131072;
constexpr int LDSCTL_OFF = RING_BYTES, MISC_OFF = LDSCTL_OFF + 320;
constexpr int LDS_BYTES = 147456;

#define GAS __attribute__((address_space(1)))
#define LAS __attribute__((address_space(3)))
typedef unsigned short bf16;
typedef unsigned v4u __attribute__((ext_vector_type(4)));
typedef unsigned v2u __attribute__((ext_vector_type(2)));
typedef float f32x4 __attribute__((ext_vector_type(4)));
typedef short bf16x8 __attribute__((ext_vector_type(8)));
typedef short s16x4 __attribute__((ext_vector_type(4)));
typedef GAS unsigned gu32;
typedef _Float16 f16;
typedef _Float16 f16v2 __attribute__((ext_vector_type(2)));
#define RLX_AGENT __ATOMIC_RELAXED, __HIP_MEMORY_SCOPE_AGENT
#define LDS_WAIT() asm volatile("s_waitcnt lgkmcnt(0)" ::: "memory")
#define VM_WAIT() asm volatile("s_waitcnt vmcnt(0)" ::: "memory")
#define WG_BAR() do { asm volatile("s_waitcnt lgkmcnt(0)" ::: "memory"); __builtin_amdgcn_s_barrier(); asm volatile("" ::: "memory"); } while (0)
__device__ __forceinline__ unsigned f2bf(float f) { unsigned u = __builtin_bit_cast(unsigned, f); return (u + 0x7fffu + ((u >> 16) & 1u)) >> 16; }
typedef __bf16 bf16v2 __attribute__((ext_vector_type(2)));
typedef float f32v2 __attribute__((ext_vector_type(2)));
__device__ __forceinline__ unsigned pk2(float lo, float hi) { const f32v2 v = {lo, hi}; return __builtin_bit_cast(unsigned, __builtin_convertvector(v, bf16v2)); }
__device__ __forceinline__ float bflo(unsigned w) { return __builtin_bit_cast(float, w << 16); }
__device__ __forceinline__ float bfhi(unsigned w) { return __builtin_bit_cast(float, w & 0xffff0000u); }
__device__ __forceinline__ float fexp(float x) { return __builtin_amdgcn_exp2f(x * 1.4426950408889634f); }
__device__ __forceinline__ float fsigm(float x) { return __builtin_amdgcn_rcpf(1.f + fexp(-x)); }
__device__ __forceinline__ float fexpn_c(float x) { return __builtin_amdgcn_exp2f(fminf(x * -1.4426950408889634f, 60.f)); }
__device__ __forceinline__ void fsigm2(float x0, float x1, float& s0, float& s1) { const float a0 = 1.f + fexpn_c(x0), a1 = 1.f + fexpn_c(x1), r = __builtin_amdgcn_rcpf(a0 * a1); s0 = r * a1; s1 = r * a0; }
__device__ __forceinline__ float flog2(float x) { return __builtin_amdgcn_logf(x); }
__device__ __forceinline__ float fex2(float x) { return __builtin_amdgcn_exp2f(x); }

#define XB_TMO      128
#define XB_XCNT(j)  (256  + 64 * (j))
#define XB_XSUB(j)  (1280 + 64 * (j))
#define XB_XGEN(j)  (2304 + 64 * (j))
#define XB_TOP      3328
#define XB_TOPGEN   3392
#define XCD_BAR_WORDS 3456
#define XB_SPIN_CAP (1u << 18)
__device__ __forceinline__ unsigned xb_ld(unsigned* p)              { return __hip_atomic_load(p, __ATOMIC_RELAXED, __HIP_MEMORY_SCOPE_AGENT); }
__device__ __forceinline__ unsigned xb_add(unsigned* p, unsigned v) { return __hip_atomic_fetch_add(p, v, __ATOMIC_RELAXED, __HIP_MEMORY_SCOPE_AGENT); }
__device__ __forceinline__ unsigned xb_xcc_id() { return (unsigned)__builtin_amdgcn_s_getreg((3 << 11) | 20) & 0xFu; }
#define XB_SPIN(cond, bar) do { unsigned _sp = 0; while (cond) { __builtin_amdgcn_s_sleep(1); \
    if ((++_sp & 255u) == 0u) { if (xb_ld(&(bar)[XB_TMO])) break; if (_sp > XB_SPIN_CAP) { atomicAdd(&(bar)[XB_TMO], 1u); break; } } } } while (0)
struct XcdBarrier { unsigned* bar; unsigned x; volatile LAS unsigned* st; };
__device__ __forceinline__ XcdBarrier xcd_barrier_post(unsigned* bar, volatile LAS unsigned* st) {
    XcdBarrier b; b.bar = bar; b.x = xb_xcc_id(); b.st = st;
    if (threadIdx.x == 0) (void)xb_add(&bar[XB_XCNT(b.x)], 1u);
    return b;
}
__device__ __forceinline__ void xcd_barrier_complete(unsigned* bar, unsigned x, unsigned& nloc, unsigned& nx) {
    const unsigned G = gridDim.x * gridDim.y * gridDim.z;
    unsigned sum, cnt, mine, sp = 0u;
    for (;;) {
        sum = 0u; cnt = 0u; mine = 0u;
#pragma unroll
        for (unsigned j = 0; j < 16; ++j) { const unsigned c = xb_ld(&bar[XB_XCNT(j)]); sum += c; cnt += (c > 0u) ? 1u : 0u; mine = (j == x) ? c : mine; }
        if (sum == G) break;
        __builtin_amdgcn_s_sleep(1);
        if ((++sp & 255u) == 0u) { if (xb_ld(&bar[XB_TMO])) break; if (sp > XB_SPIN_CAP) { atomicAdd(&bar[XB_TMO], 1u); break; } }
    }
    nloc = mine > 0u ? mine : 1u; nx = cnt > 0u ? cnt : 1u;
}
__device__ __forceinline__ void xcd_barrier(const XcdBarrier& b) {
    asm volatile("s_waitcnt vmcnt(0)" ::: "memory");
    __syncthreads();
    if (threadIdx.x == 0) {
        unsigned* bar = b.bar;
        __builtin_amdgcn_s_waitcnt(0);
        unsigned nloc = b.st[0], nx = b.st[1];
        if (nloc == 0u) { xcd_barrier_complete(bar, b.x, nloc, nx); b.st[0] = nloc; b.st[1] = nx; }
        const unsigned old = xb_add(&bar[XB_XSUB(b.x)], 1u);
        const unsigned gen = old / nloc;
        if (old + 1u == (gen + 1u) * nloc) {
            __builtin_amdgcn_fence(__ATOMIC_RELEASE, "agent");
            asm volatile("s_waitcnt vmcnt(0)" ::: "memory");
            const unsigned og = xb_add(&bar[XB_TOP], 1u);
            const unsigned tg = og / nx;
            if (og + 1u == (tg + 1u) * nx) xb_add(&bar[XB_TOPGEN], 1u);
            else XB_SPIN(xb_ld(&bar[XB_TOPGEN]) == tg, bar);
            __builtin_amdgcn_fence(__ATOMIC_ACQUIRE, "agent");
            xb_add(&bar[XB_XGEN(b.x)], 1u);
            asm volatile("s_waitcnt vmcnt(0)" ::: "memory");
        } else {
            XB_SPIN(xb_ld(&bar[XB_XGEN(b.x)]) == gen, bar);
            __builtin_amdgcn_fence(__ATOMIC_ACQUIRE, "agent");
            asm volatile("s_waitcnt vmcnt(0)" ::: "memory");
        }
    }
    __syncthreads();
}

struct Frame {
    LAS unsigned char* lds;
    volatile LAS unsigned* MISC;
    gu32* ctl;
    int tid, lane, wave;
    int G;
    const float *x_prompt, *x_sample, *state_hgrn, *state_pool, *norm_g, *w_in, *lb_logits, *hgrn_norm_g, *w_proj_a, *w_pool, *pool_scale, *w_proj_b, *w_out, *final_norm_g;
    float* out;
    bf16 *WinT, *WabT, *WoutT, *WpT;
    bf16 *XN, *QF, *V, *GA, *U, *GB, *MA, *MB, *OY, *MG;
    f16* LOGF; float *PART, *DTOT, *UWS, *SUF;
};

__device__ __forceinline__ float wave_sum(float v) {
#pragma unroll
    for (int o = 1; o < 64; o <<= 1) v += __shfl_xor(v, o);
    return v;
}
__device__ __forceinline__ const float* xrow_ptr(const Frame& F, int m) { return m < MP ? F.x_prompt + (size_t)m * D : F.x_sample + (size_t)(m - MP) * D; }

__host__ __device__ __forceinline__ size_t hm_off(int m, int c) { return ((size_t)(c >> 7) * M + m) * 128 + (c & 127); }
__device__ __forceinline__ int win_row_of_col(int c) { if (c < 3072) return c; const int b = c >= 4096, a = c - (b ? 4096 : 3072); return 3072 + ((a >> 7) << 8) + (b << 7) + (a & 127); }
template <bool MAPROWS = false>
__device__ __forceinline__ void p0_transpose_item(const float* W, int K, int N, bf16* WT, int opitch, LAS float* scr, int item, int lane) {
    const int nblk = N / 32, kb = item / nblk, nb = item % nblk, k0 = 64 * kb, n0 = 32 * nb;
#pragma unroll 8
    for (int i = 0; i < 32; ++i) { const int kk = 2 * i + (lane >> 5); scr[kk * 33 + (lane & 31)] = W[(size_t)(k0 + kk) * N + n0 + (lane & 31)]; }
    LDS_WAIT(); asm volatile("" ::: "memory");
    const int c = lane & 7;
#pragma unroll
    for (int j = 0; j < 4; ++j) { const int n = (lane >> 3) + 8 * j; const LAS float* s = scr + (8 * c) * 33 + n;
        v4u o; o.x = pk2(s[0 * 33], s[1 * 33]); o.y = pk2(s[2 * 33], s[3 * 33]); o.z = pk2(s[4 * 33], s[5 * 33]); o.w = pk2(s[6 * 33], s[7 * 33]);
        *(GAS v4u*)(WT + (size_t)(MAPROWS ? win_row_of_col(n0 + n) : n0 + n) * opitch + k0 + 8 * c) = o; }
    LDS_WAIT(); asm volatile("" ::: "memory");
}
template <int NR>
__device__ __forceinline__ void rms_rows_to_bf16(const Frame& F, int m0, int mstride, const f32x4 (&g)[4]) {
    f32x4 v[NR][4];
#pragma unroll
    for (int r = 0; r < NR; ++r) { const GAS f32x4* xr = (const GAS f32x4*)xrow_ptr(F, m0 + r * mstride) + F.lane;
#pragma unroll
        for (int j = 0; j < 4; ++j) v[r][j] = xr[64 * j]; }
#pragma unroll
    for (int r = 0; r < NR; ++r) { float s = 0.f;
#pragma unroll
        for (int j = 0; j < 4; ++j) s += (v[r][j].x * v[r][j].x + v[r][j].y * v[r][j].y) + (v[r][j].z * v[r][j].z + v[r][j].w * v[r][j].w);
        const float rstd = __builtin_amdgcn_rsqf(wave_sum(s) * (1.f / D) + EPS);
        GAS unsigned long long* o8 = (GAS unsigned long long*)(F.XN + (size_t)(m0 + r * mstride) * D) + F.lane;
#pragma unroll
        for (int j = 0; j < 4; ++j) o8[64 * j] = (unsigned long long)pk2(v[r][j].x * rstd * g[j].x, v[r][j].y * rstd * g[j].y) | ((unsigned long long)pk2(v[r][j].z * rstd * g[j].z, v[r][j].w * rstd * g[j].w) << 32); }
}
__device__ __forceinline__ void p0_prologue(Frame& F) {
    LAS float* scr = (LAS float*)(F.lds + RING_OFF + F.wave * 16384);
    const int gw = blockIdx.x * NWAVES + F.wave, NGW = F.G * NWAVES;
    constexpr int I_IN = (D / 64) * (DIN / 32), I_A = (WA / 64) * (D / 32), I_B = (WB / 64) * (D / 32), I_O = (D / 64) * (D / 32), I_P = (128 / 64) * (128 / 32);
    constexpr int NITEMS = I_IN + I_A + I_B + I_O + 4 * I_P;
    for (int it = gw; it < NITEMS; it += NGW) {
        int r = it;
        if (r < I_IN) { p0_transpose_item<true>(F.w_in, D, DIN, F.WinT, D, scr, r, F.lane); continue; } r -= I_IN;
        if (r < I_A) { p0_transpose_item(F.w_proj_a, WA, D, F.WabT, 1024, scr, r, F.lane); continue; } r -= I_A;
        if (r < I_B) { p0_transpose_item(F.w_proj_b, WB, D, F.WabT + 512, 1024, scr, r, F.lane); continue; } r -= I_B;
        if (r < I_O) { p0_transpose_item(F.w_out, D, D, F.WoutT, D, scr, r, F.lane); continue; } r -= I_O;
        const int g = r / I_P; r -= g * I_P;
        p0_transpose_item(F.w_pool + (size_t)g * 128 * 128, 128, 128, F.WpT + (size_t)g * 128 * 128, 128, scr, r, F.lane);
    }
    {   f32x4 g[4];
#pragma unroll
        for (int j = 0; j < 4; ++j) g[j] = ((const GAS f32x4*)F.norm_g + F.lane)[64 * j];
        int m = gw;
        for (; m + 3 * NGW < M; m += 4 * NGW) rms_rows_to_bf16<4>(F, m, NGW, g);
        for (; m < M; m += NGW) rms_rows_to_bf16<1>(F, m, NGW, g);
    }
    for (int i = blockIdx.x * (NWAVES * 64) + F.tid; i < DB * (WB / 4); i += F.G * NWAVES * 64) {
        const int c4 = i % (WB / 4), b = i / (WB / 4), w = 2 << (c4 >> 5);
        const float* bp = F.state_pool + (size_t)b * PB * WB + c4 * 4;
        f32x4 r[PB];
#pragma unroll
        for (int j = 0; j < PB; ++j) r[j] = (j >= PB - (w - 1)) ? *(const f32x4*)(bp + (size_t)j * WB) : (f32x4){0.f, 0.f, 0.f, 0.f};
        f32x4 acc = (f32x4){0.f, 0.f, 0.f, 0.f};
#pragma unroll
        for (int n = 1; n <= PB; ++n) { acc += r[PB - n];
#pragma unroll
            for (int t = 0; t < 4; ++t) if (n == w - 1 - t) *(f32x4*)(F.SUF + ((size_t)(b * 4 + t)) * WB + c4 * 4) = acc; }
#pragma unroll
        for (int t = 0; t < 4; ++t) if (w - 1 - t <= 0) *(f32x4*)(F.SUF + ((size_t)(b * 4 + t)) * WB + c4 * 4) = (f32x4){0.f, 0.f, 0.f, 0.f};
    }
    float* sps = F.out + O_SPS;
    for (int i = blockIdx.x * (NWAVES * 64) + F.tid; i < DB * 11 * (WB / 4); i += F.G * NWAVES * 64) {
        const int c4 = i % (WB / 4), j = (i / (WB / 4)) % 11, b = i / ((WB / 4) * 11);
        *(f32x4*)(sps + ((size_t)b * PB + j) * WB + c4 * 4) = *(const f32x4*)(F.state_pool + ((size_t)b * PB + j + 4) * WB + c4 * 4);
    }
}

struct EpiZ {
    static constexpr bool PERM = true, AFTER_DRAIN = false, HAS_MID = false;
    bf16 *QF, *V, *GA, *U, *GB, *MA, *MB; f16* LOGF; const float* lb_logits; float* spp; float* sps;
    __device__ __forceinline__ void operator()(const f32x4 (&acc)[2][2][4][2], const pg8::Unit& u, int wr, int wc, int fr, int fq, int, int) const {
        const int row0 = u.r0 + wr * 64 + fr, cl0 = wc * 32 + 8 * fq;
        const int pn = u.pn, nai = u.half ? 1 : 2;
        if (pn >= 2 && pn < 4) {
            float lb[2][8];
#pragma unroll
            for (int bj = 0; bj < 2; ++bj) { const int c = (pn - 2) * 256 + bj * 128 + cl0;
#pragma unroll
                for (int j = 0; j < 8; ++j) lb[bj][j] = fsigm(lb_logits[c + j] - lb_logits[WA + c + j]); }
#pragma unroll
            for (int ai = 0; ai < 2; ++ai) if (ai < nai)
#pragma unroll
                for (int m = 0; m < 4; ++m) { const int row = row0 + ai * 128 + m * 16;
#pragma unroll
                    for (int bj = 0; bj < 2; ++bj) { const int c = (pn - 2) * 256 + bj * 128 + cl0; f32x4 o0, o1;
#pragma unroll
                        for (int j = 0; j < 4; ++j) { float s0, s1; fsigm2(acc[ai][bj][m][0][j], acc[ai][bj][m][1][j], s0, s1);
                                                      o0[j] = flog2(lb[bj][j] + (1.f - lb[bj][j]) * s0); o1[j] = flog2(lb[bj][4 + j] + (1.f - lb[bj][4 + j]) * s1); }
                        v4u w; w.x = __builtin_bit_cast(unsigned, (f16v2){(f16)o0[0], (f16)o0[1]}); w.y = __builtin_bit_cast(unsigned, (f16v2){(f16)o0[2], (f16)o0[3]});
                        w.z = __builtin_bit_cast(unsigned, (f16v2){(f16)o1[0], (f16)o1[1]}); w.w = __builtin_bit_cast(unsigned, (f16v2){(f16)o1[2], (f16)o1[3]});
                        *(v4u*)(LOGF + hm_off(row, c)) = w; } }
            return;
        }
        if (pn >= 12) {
            const int c = ((pn - 12) >> 1) * 256 + ((pn - 12) & 1) * 128 + cl0;
#pragma unroll
            for (int ai = 0; ai < 2; ++ai) if (ai < nai)
#pragma unroll
                for (int m = 0; m < 4; ++m) { const int row = row0 + ai * 128 + m * 16; float rr[8], gg[8];
#pragma unroll
                    for (int n = 0; n < 2; ++n)
#pragma unroll
                        for (int j = 0; j < 4; ++j) { const float a = 1.f + fexpn_c(acc[ai][0][m][n][j]), b = 1.f + fexpn_c(acc[ai][1][m][n][j]), r = __builtin_amdgcn_rcpf(a * b);
                            gg[4 * n + j] = a * r; rr[4 * n + j] = (b * b) * r; }
                    pg8::u32x4 w; w.x = pg8::cvt_pk_bf16(rr[0], rr[1]); w.y = pg8::cvt_pk_bf16(rr[2], rr[3]); w.z = pg8::cvt_pk_bf16(rr[4], rr[5]); w.w = pg8::cvt_pk_bf16(rr[6], rr[7]);
                    *(pg8::u32x4*)(MA + (size_t)row * 1024 + c) = w;
                    w.x = pg8::cvt_pk_bf16(gg[0], gg[1]); w.y = pg8::cvt_pk_bf16(gg[2], gg[3]); w.z = pg8::cvt_pk_bf16(gg[4], gg[5]); w.w = pg8::cvt_pk_bf16(gg[6], gg[7]);
                    *(pg8::u32x4*)(MB + (size_t)row * 1024 + c) = w; }
            return;
        }
        bf16* base; int ct, mode; bool hm = true;
        if (pn < 2) { base = QF; ct = pn; mode = 2; }
        else if (pn < 6) { base = V; ct = pn - 4; mode = 0; }
        else if (pn < 8) { base = GA; ct = pn - 6; mode = 1; }
        else if (pn < 10) { base = U; ct = pn - 8; mode = 0; hm = false; }
        else { base = GB; ct = pn - 10; mode = 1; hm = false; }
        const float sc = mode == 2 ? 0.08838834764831845f : 1.f;
#pragma unroll
        for (int ai = 0; ai < 2; ++ai) if (ai < nai)
#pragma unroll
            for (int m = 0; m < 4; ++m) { const int row = row0 + ai * 128 + m * 16;
#pragma unroll
                for (int bj = 0; bj < 2; ++bj) { const int c = ct * 256 + bj * 128 + cl0;
                    f32x4 v0 = acc[ai][bj][m][0], v1 = acc[ai][bj][m][1];
                    if (mode != 0) {
#pragma unroll
                        for (int j = 0; j < 4; ++j) { float s0, s1; fsigm2(v0[j], v1[j], s0, s1); v0[j] = v0[j] * s0 * sc; v1[j] = v1[j] * s1 * sc; }
                    }
                    pg8::u32x4 w; w.x = pg8::cvt_pk_bf16(v0[0], v0[1]); w.y = pg8::cvt_pk_bf16(v0[2], v0[3]); w.z = pg8::cvt_pk_bf16(v1[0], v1[1]); w.w = pg8::cvt_pk_bf16(v1[2], v1[3]);
                    *(pg8::u32x4*)(base + (hm ? hm_off(row, c) : (size_t)row * 512 + c)) = w;
                    if (pn >= 8 && pn < 10) {
                        float* dst = nullptr;
                        if (row >= MP) { const int sr = row - MP; dst = sps + ((size_t)(sr >> 2) * PB + 11 + (sr & 3)) * WB + c; }
                        else if ((row & (T - 1)) >= T - PB) dst = spp + ((size_t)(row >> 11) * PB + ((row & (T - 1)) - (T - PB))) * WB + c;
                        if (dst) { *(f32x4*)dst = acc[ai][bj][m][0]; *(f32x4*)(dst + 4) = acc[ai][bj][m][1]; }
                    }
                } }
    }
};

constexpr int PP = 1040;
__device__ __forceinline__ void unpack8(const v4u r, float (&x)[8]) { x[0] = bflo(r.x); x[1] = bfhi(r.x); x[2] = bflo(r.y); x[3] = bfhi(r.y); x[4] = bflo(r.z); x[5] = bfhi(r.z); x[6] = bflo(r.w); x[7] = bfhi(r.w); }
template <int W>
__device__ __forceinline__ void pool_rows_prompt(const Frame& F, int m0, LAS unsigned char* PA) {
    int tid_ = F.tid; asm volatile("" : "+v"(tid_));
    const int c8 = tid_ >> 3, t0 = 8 * (tid_ & 7), m = m0 + t0, tseq0 = m & (T - 1);
    v4u r[W + 7];
#pragma unroll
    for (int jj = 0; jj < W + 7; ++jj) { const int dt = jj - (W - 1);
        r[jj] = (tseq0 + dt) >= 0 ? *(const GAS v4u*)(F.U + (size_t)(m + dt) * 512 + c8 * 8) : (v4u){0u, 0u, 0u, 0u}; }
    float a[8], x[8];
#pragma unroll
    for (int j = 0; j < 8; ++j) a[j] = 0.f;
#pragma unroll
    for (int jj = 0; jj < W - 1; ++jj) { unpack8(r[jj], x);
#pragma unroll
        for (int j = 0; j < 8; ++j) a[j] += x[j]; }
#pragma unroll
    for (int i = 0; i < 8; ++i) {
        unpack8(r[W - 1 + i], x);
#pragma unroll
        for (int j = 0; j < 8; ++j) a[j] += x[j];
        const int pos = tseq0 + i; const float ic = 1.f / (float)((pos + 1) < W ? (pos + 1) : W);
        v4u o; o.x = pk2(a[0] * ic - x[0], a[1] * ic - x[1]); o.y = pk2(a[2] * ic - x[2], a[3] * ic - x[3]); o.z = pk2(a[4] * ic - x[4], a[5] * ic - x[5]); o.w = pk2(a[6] * ic - x[6], a[7] * ic - x[7]);
        *(LAS v4u*)(PA + (t0 + i) * PP + c8 * 16) = o;
        unpack8(r[i], x);
#pragma unroll
        for (int j = 0; j < 8; ++j) a[j] -= x[j];
    }
}
template <int W>
__device__ __forceinline__ void pool_rows_sample(const Frame& F, int m0, LAS unsigned char* PA) {
    int tid_ = F.tid; asm volatile("" : "+v"(tid_));
    const int c8 = tid_ >> 3, t0 = 8 * (tid_ & 7), m = m0 + t0, b0 = (m - MP) >> 2;
    v4u r[8];
#pragma unroll
    for (int i = 0; i < 8; ++i) r[i] = *(const GAS v4u*)(F.U + (size_t)(m + i) * 512 + c8 * 8);
    f32x4 s0[8], s1[8];
#pragma unroll
    for (int i = 0; i < 8; ++i) { const float* sp = F.SUF + ((size_t)((b0 + (i >> 2)) * 4 + (i & 3))) * WB + c8 * 8; s0[i] = *(const f32x4*)sp; s1[i] = *(const f32x4*)(sp + 4); }
#pragma unroll
    for (int i = 0; i < 8; ++i) {
        const int tq = i & 3;
        float a[8], x[8];
        a[0] = s0[i].x; a[1] = s0[i].y; a[2] = s0[i].z; a[3] = s0[i].w; a[4] = s1[i].x; a[5] = s1[i].y; a[6] = s1[i].z; a[7] = s1[i].w;
#pragma unroll
        for (int j = 0; j <= tq && j < W; ++j) { unpack8(r[i - j], x);
#pragma unroll
            for (int e = 0; e < 8; ++e) a[e] += x[e]; }
        unpack8(r[i], x);
        const float ic = 1.f / (float)W;
        v4u o; o.x = pk2(a[0] * ic - x[0], a[1] * ic - x[1]); o.y = pk2(a[2] * ic - x[2], a[3] * ic - x[3]); o.z = pk2(a[4] * ic - x[4], a[5] * ic - x[5]); o.w = pk2(a[6] * ic - x[6], a[7] * ic - x[7]);
        *(LAS v4u*)(PA + (t0 + i) * PP + c8 * 16) = o;
    }
}
template <int EXP = 0>
__device__ __forceinline__ void pool_item(Frame& F, int it) {
    int lane = F.lane, tid = F.tid; const int m0 = it * 64, wv = F.wave;
    asm volatile("" : "+v"(lane), "+v"(tid));
    LAS unsigned char* PA = F.lds + RING_OFF;
    const bool smp = m0 >= MP;
    const int i = lane & 15, q = lane >> 4, g2 = wv >> 1, half = wv & 1;
    bf16x8 wf[4][4]; f32x4 ps[4];
    v4u gbq[8];
#pragma unroll
    for (int k = 0; k < 8; ++k) { const int id = tid + 512 * k, t = id >> 6, c8 = id & 63; gbq[k] = *(const GAS v4u*)(F.GB + (size_t)(m0 + t) * 512 + c8 * 8); }
#pragma unroll
    for (int nt = 0; nt < 4; ++nt) ps[nt] = *(const f32x4*)(F.pool_scale + g2 * 128 + 64 * half + 16 * nt + 4 * q);
    __builtin_amdgcn_sched_barrier(0);
    if (EXP != 2) {
        const int g = wv >> 1;
        if (!smp) { if (g == 0) pool_rows_prompt<2>(F, m0, PA); else if (g == 1) pool_rows_prompt<4>(F, m0, PA); else if (g == 2) pool_rows_prompt<8>(F, m0, PA); else pool_rows_prompt<16>(F, m0, PA); }
        else { if (g == 0) pool_rows_sample<2>(F, m0, PA); else if (g == 1) pool_rows_sample<4>(F, m0, PA); else if (g == 2) pool_rows_sample<8>(F, m0, PA); else pool_rows_sample<16>(F, m0, PA); }
    }
    __builtin_amdgcn_sched_barrier(0);
#pragma unroll
    for (int nt = 0; nt < 4; ++nt)
#pragma unroll
        for (int ks = 0; ks < 4; ++ks) wf[nt][ks] = *(const GAS bf16x8*)(F.WpT + ((size_t)g2 * 128 + 64 * half + 16 * nt + i) * 128 + 32 * ks + 8 * q);
    __builtin_amdgcn_sched_barrier(0);
    WG_BAR();
    if (EXP != 1) {
        f32x4 acc[4][4];
#pragma unroll
        for (int mt = 0; mt < 4; ++mt)
#pragma unroll
            for (int nt = 0; nt < 4; ++nt) acc[mt][nt] = (f32x4){0.f, 0.f, 0.f, 0.f};
#pragma unroll
        for (int mt = 0; mt < 4; ++mt)
#pragma unroll
            for (int ks = 0; ks < 4; ++ks) { const bf16x8 bf = *(const LAS bf16x8*)(PA + (16 * mt + i) * PP + (g2 * 128 + 32 * ks + 8 * q) * 2);
#pragma unroll
                for (int nt = 0; nt < 4; ++nt) acc[mt][nt] = __builtin_amdgcn_mfma_f32_16x16x32_bf16(wf[nt][ks], bf, acc[mt][nt], 0, 0, 0); }
        WG_BAR();
#pragma unroll
        for (int mt = 0; mt < 4; ++mt)
#pragma unroll
            for (int nt = 0; nt < 4; ++nt) { const int col = g2 * 128 + 64 * half + 16 * nt + 4 * q;
                v2u o; o.x = pk2(acc[mt][nt][0] * ps[nt].x, acc[mt][nt][1] * ps[nt].y); o.y = pk2(acc[mt][nt][2] * ps[nt].z, acc[mt][nt][3] * ps[nt].w);
                *(LAS v2u*)(PA + (16 * mt + i) * PP + col * 2) = o; }
        WG_BAR();
#pragma unroll
        for (int k = 0; k < 8; ++k) { const int id = tid + 512 * k, t = id >> 6, c8 = id & 63;
            const v4u mx = *(const LAS v4u*)(PA + t * PP + c8 * 16), g = gbq[k];
            v4u o; o.x = pk2(bflo(mx.x) * bflo(g.x), bfhi(mx.x) * bfhi(g.x)); o.y = pk2(bflo(mx.y) * bflo(g.y), bfhi(mx.y) * bfhi(g.y));
            o.z = pk2(bflo(mx.z) * bflo(g.z), bfhi(mx.z) * bfhi(g.z)); o.w = pk2(bflo(mx.w) * bflo(g.w), bfhi(mx.w) * bfhi(g.w));
            *(GAS v4u*)(F.OY + (size_t)(m0 + t) * 1024 + 512 + c8 * 8) = o; }
    }
    WG_BAR();
}

constexpr int PQ = 272, PT = 80, POB = 528;
constexpr int IMG_QE = 0, IMG_KE = IMG_QE + 32 * PQ, IMG_K2T = IMG_KE + 32 * PQ, IMG_VT = IMG_K2T + 128 * PT, IMG_DEC = IMG_VT + 128 * PT, IMG_ER = IMG_DEC + 512, IMG_BYTES = IMG_ER + 512;
constexpr int L_OB0 = 2 * IMG_BYTES, L_HEND = L_OB0 + 2 * 32 * POB;
static_assert(L_HEND <= RING_BYTES && IMG_K2T % 16 == 0 && IMG_VT % 16 == 0 && IMG_DEC % 16 == 0 && IMG_ER % 16 == 0 && IMG_BYTES % 16 == 0 && L_OB0 % 16 == 0, "hgrn lds map");
struct HgrnItem {
    int m0, nchunks, h;
    const float* s_start;
    float* s_out;
    float* u_out; float* d_out;
};
#ifndef HG_PFD
#define HG_PFD 1
#endif
struct HgRaw { float lf[8][2]; unsigned q[8], v[8]; };
template <bool FULL>
__device__ __forceinline__ void hg_load(const Frame& F, const HgrnItem& it, HgRaw& r, int ck, int tg, int d0) {
    const size_t rb = ((size_t)it.h * M + it.m0 + 32 * ck + 8 * tg) * 128 + d0;
#pragma unroll
    for (int j = 0; j < 8; ++j) { const f16v2 l2 = *(const f16v2*)(F.LOGF + rb + (size_t)j * 128); r.lf[j][0] = (float)l2.x; r.lf[j][1] = (float)l2.y;
        r.q[j] = FULL ? *(const unsigned*)(F.QF + rb + (size_t)j * 128) : 0u; r.v[j] = *(const unsigned*)(F.V + rb + (size_t)j * 128); }
}
template <bool FULL>
__device__ __forceinline__ void hg_a_stage(const Frame& F, const HgrnItem& it, LAS unsigned char* L, const HgRaw& cur, HgRaw& nxt, int s, int n, int lane, int tg, int d0, int nt_, int nc16, float& cum0, float& cum1, const f32x4 (&gn)[4]) {
    v4u ga0 = (v4u){0u, 0u, 0u, 0u}, ga1 = ga0;
    const size_t noff = ((size_t)it.h * M + it.m0 + 32 * (s - 2) + nt_) * 128 + 16 * nc16;
    if (FULL && s >= 2) { ga0 = *(const GAS v4u*)(F.GA + noff); ga1 = *(const GAS v4u*)(F.GA + noff + 8); }
    __builtin_amdgcn_sched_barrier(0);
    if (s + HG_PFD < n) hg_load<FULL>(F, it, nxt, s + HG_PFD, tg, d0);
    __builtin_amdgcn_sched_barrier(0);
    if (s < n) {
        LAS unsigned char* IM = L + (s & 1) * IMG_BYTES;
        float c0[8], c1[8];
        c0[0] = cur.lf[0][0]; c1[0] = cur.lf[0][1];
#pragma unroll
        for (int j = 1; j < 8; ++j) { c0[j] = c0[j - 1] + cur.lf[j][0]; c1[j] = c1[j - 1] + cur.lf[j][1]; }
        float t0[4], t1[4];
#pragma unroll
        for (int g = 0; g < 4; ++g) { t0[g] = __shfl(c0[7], (lane & 15) + 16 * g); t1[g] = __shfl(c1[7], (lane & 15) + 16 * g); }
        const float f0 = __shfl(cur.lf[0][0], (lane & 15) + 32), f1 = __shfl(cur.lf[0][1], (lane & 15) + 32);
        const float off0 = tg == 0 ? 0.f : (tg == 1 ? t0[0] : (tg == 2 ? t0[0] + t0[1] : t0[0] + t0[1] + t0[2]));
        const float off1 = tg == 0 ? 0.f : (tg == 1 ? t1[0] : (tg == 2 ? t1[0] + t1[1] : t1[0] + t1[1] + t1[2]));
        const float b31_0 = (t0[0] + t0[1]) + (t0[2] + t0[3]), b31_1 = (t1[0] + t1[1]) + (t1[2] + t1[3]);
        const float r0 = t0[0] + t0[1] + f0, r1 = t1[0] + t1[1] + f1;
        const float er0 = fex2(r0), er1 = fex2(r1), ew0 = fex2(b31_0 - r0), ew1 = fex2(b31_1 - r1);
        float k2a[8], k2b[8];
#pragma unroll
        for (int j = 0; j < 8; ++j) {
            const float ba = off0 + c0[j], bb = off1 + c1[j];
            const float ka = 1.f - fex2(cur.lf[j][0]), kb = 1.f - fex2(cur.lf[j][1]);
            if (FULL) {
                const float e1a = fex2(ba - r0), e1b = fex2(bb - r1);
                const float kea = ka * __builtin_amdgcn_rcpf(e1a), keb = kb * __builtin_amdgcn_rcpf(e1b);
                const float qea = bflo(cur.q[j]) * e1a, qeb = bfhi(cur.q[j]) * e1b;
                const int srow = 8 * tg + j;
                *(LAS unsigned*)(IM + IMG_QE + srow * PQ + d0 * 2) = pk2(qea, qeb);
                *(LAS unsigned*)(IM + IMG_KE + srow * PQ + d0 * 2) = pk2(kea, keb);
                k2a[j] = kea * ew0; k2b[j] = keb * ew1;
            } else { k2a[j] = ka * fex2(b31_0 - ba); k2b[j] = kb * fex2(b31_1 - bb); }
        }
        { v4u o; o.x = pk2(k2a[0], k2a[1]); o.y = pk2(k2a[2], k2a[3]); o.z = pk2(k2a[4], k2a[5]); o.w = pk2(k2a[6], k2a[7]); *(LAS v4u*)(IM + IMG_K2T + d0 * PT + tg * 16) = o; }
        { v4u o; o.x = pk2(k2b[0], k2b[1]); o.y = pk2(k2b[2], k2b[3]); o.z = pk2(k2b[4], k2b[5]); o.w = pk2(k2b[6], k2b[7]); *(LAS v4u*)(IM + IMG_K2T + (d0 + 1) * PT + tg * 16) = o; }
        const unsigned* vv = cur.v;
        { v4u o; o.x = (vv[0] & 0xffffu) | (vv[1] << 16); o.y = (vv[2] & 0xffffu) | (vv[3] << 16); o.z = (vv[4] & 0xffffu) | (vv[5] << 16); o.w = (vv[6] & 0xffffu) | (vv[7] << 16); *(LAS v4u*)(IM + IMG_VT + d0 * PT + tg * 16) = o; }
        { v4u o; o.x = (vv[0] >> 16) | (vv[1] & 0xffff0000u); o.y = (vv[2] >> 16) | (vv[3] & 0xffff0000u); o.z = (vv[4] >> 16) | (vv[5] & 0xffff0000u); o.w = (vv[6] >> 16) | (vv[7] & 0xffff0000u); *(LAS v4u*)(IM + IMG_VT + (d0 + 1) * PT + tg * 16) = o; }
        if (tg == 0) { *(LAS f32v2*)(IM + IMG_DEC + d0 * 4) = (f32v2){fex2(b31_0), fex2(b31_1)}; if (FULL) *(LAS f32v2*)(IM + IMG_ER + d0 * 4) = (f32v2){er0, er1}; cum0 += b31_0; cum1 += b31_1; }
    }
    if (FULL && s >= 2) {
        const LAS unsigned char* OBs = L + L_OB0 + (s & 1) * (32 * POB) + nt_ * POB + nc16 * 64;
        const f32x4 x0 = *(const LAS f32x4*)(OBs), x1 = *(const LAS f32x4*)(OBs + 16), x2 = *(const LAS f32x4*)(OBs + 32), x3 = *(const LAS f32x4*)(OBs + 48);
        float ss = ((x0.x * x0.x + x0.y * x0.y) + (x0.z * x0.z + x0.w * x0.w)) + ((x1.x * x1.x + x1.y * x1.y) + (x1.z * x1.z + x1.w * x1.w))
                 + ((x2.x * x2.x + x2.y * x2.y) + (x2.z * x2.z + x2.w * x2.w)) + ((x3.x * x3.x + x3.y * x3.y) + (x3.z * x3.z + x3.w * x3.w));
        ss += __shfl_xor(ss, 1); ss += __shfl_xor(ss, 2); ss += __shfl_xor(ss, 4);
        const float rstd = __builtin_amdgcn_rsqf(ss * (1.f / 128.f) + EPS);
        const f32x4 g0 = gn[0] * rstd, g1 = gn[1] * rstd, g2 = gn[2] * rstd, g3 = gn[3] * rstd;
        v4u o0, o1;
        o0.x = pk2(x0.x * g0.x * bflo(ga0.x), x0.y * g0.y * bfhi(ga0.x)); o0.y = pk2(x0.z * g0.z * bflo(ga0.y), x0.w * g0.w * bfhi(ga0.y));
        o0.z = pk2(x1.x * g1.x * bflo(ga0.z), x1.y * g1.y * bfhi(ga0.z)); o0.w = pk2(x1.z * g1.z * bflo(ga0.w), x1.w * g1.w * bfhi(ga0.w));
        o1.x = pk2(x2.x * g2.x * bflo(ga1.x), x2.y * g2.y * bfhi(ga1.x)); o1.y = pk2(x2.z * g2.z * bflo(ga1.y), x2.w * g2.w * bfhi(ga1.y));
        o1.z = pk2(x3.x * g3.x * bflo(ga1.z), x3.y * g3.y * bfhi(ga1.z)); o1.w = pk2(x3.z * g3.z * bflo(ga1.w), x3.w * g3.w * bfhi(ga1.w));
        const size_t ooff = (size_t)(it.m0 + 32 * (s - 2) + nt_) * 1024 + it.h * 128 + 16 * nc16;
        *(GAS v4u*)(F.OY + ooff) = o0; *(GAS v4u*)(F.OY + ooff + 8) = o1;
    }
}
template <bool FULL>
__device__ __forceinline__ void hgrn_pipe(Frame& F, const HgrnItem& it) {
    int tid = F.tid, lane = F.lane; const int wv = F.wave;
    LAS unsigned char* L = F.lds + RING_OFF;
    constexpr int n = SCH;
    constexpr int nstage = FULL ? n + 2 : n + 1;
    WG_BAR();
    if (wv < 4) {
        asm volatile("" : "+v"(tid), "+v"(lane));
        const int dp = 16 * wv + (lane & 15), d0 = 2 * dp, tg = lane >> 4;
        const int nt_ = tid >> 3, nc16 = tid & 7;
        float cum0 = 0.f, cum1 = 0.f;
        HgRaw r[HG_PFD + 1];
        f32x4 gn[4];
#pragma unroll
        for (int j = 0; j < 4; ++j) gn[j] = FULL ? *(const f32x4*)(F.hgrn_norm_g + 16 * nc16 + 4 * j) : (f32x4){0.f, 0.f, 0.f, 0.f};
#pragma unroll
        for (int c = 0; c < HG_PFD && c < n; ++c) hg_load<FULL>(F, it, r[c], c, tg, d0);
#pragma unroll
        for (int s = 0; s < nstage; ++s) {
            hg_a_stage<FULL>(F, it, L, r[s % (HG_PFD + 1)], r[(s + HG_PFD) % (HG_PFD + 1)], s, n, lane, tg, d0, nt_, nc16, cum0, cum1, gn);
            WG_BAR();
        }
        if (it.d_out && tg == 0) *(f32v2*)(it.d_out + d0) = (f32v2){fex2(cum0), fex2(cum1)};
    } else {
        asm volatile("" : "+v"(lane));
        const int i = lane & 15, q = lane >> 4, wb = wv & 3;
        f32x4 Sacc[2][8];
#pragma unroll
        for (int sl = 0; sl < 2; ++sl)
#pragma unroll
            for (int dt = 0; dt < 8; ++dt) Sacc[sl][dt] = it.s_start ? *(const f32x4*)(it.s_start + ((size_t)(sl * 8 + dt) * 256 + wb * 64 + lane) * 4) : (f32x4){0.f, 0.f, 0.f, 0.f};
#pragma unroll 1
        for (int s = 0; s < nstage; ++s) {
            if (s >= 1 && s <= n) {
                const LAS unsigned char* IM = L + ((s - 1) & 1) * IMG_BYTES;
                f32x4 p00 = (f32x4){0.f, 0.f, 0.f, 0.f}, p01 = p00, p11 = p00;
                if (FULL) {
#pragma unroll
                    for (int ks = 0; ks < 4; ++ks) {
                        const bf16x8 a0 = *(const LAS bf16x8*)(IM + IMG_KE + i * PQ + (32 * ks + 8 * q) * 2), a1 = *(const LAS bf16x8*)(IM + IMG_KE + (16 + i) * PQ + (32 * ks + 8 * q) * 2);
                        const bf16x8 b0 = *(const LAS bf16x8*)(IM + IMG_QE + i * PQ + (32 * ks + 8 * q) * 2), b1 = *(const LAS bf16x8*)(IM + IMG_QE + (16 + i) * PQ + (32 * ks + 8 * q) * 2);
                        p00 = __builtin_amdgcn_mfma_f32_16x16x32_bf16(a0, b0, p00, 0, 0, 0);
                        p01 = __builtin_amdgcn_mfma_f32_16x16x32_bf16(a0, b1, p01, 0, 0, 0);
                        p11 = __builtin_amdgcn_mfma_f32_16x16x32_bf16(a1, b1, p11, 0, 0, 0);
                    }
#pragma unroll
                    for (int r = 0; r < 4; ++r) { const bool keep = (4 * q + r) <= i; p00[r] = keep ? p00[r] : 0.f; p11[r] = keep ? p11[r] : 0.f; }
                }
                v4u pa0, pa1; pa0.x = pk2(p00[0], p00[1]); pa0.y = pk2(p00[2], p00[3]); pa0.z = 0u; pa0.w = 0u;
                pa1.x = pk2(p01[0], p01[1]); pa1.y = pk2(p01[2], p01[3]); pa1.z = pk2(p11[0], p11[1]); pa1.w = pk2(p11[2], p11[3]);
                const int dv0 = 32 * wb + i, dv1 = dv0 + 16;
                const bf16x8 vnat0 = *(const LAS bf16x8*)(IM + IMG_VT + dv0 * PT + 16 * q), vnat1 = *(const LAS bf16x8*)(IM + IMG_VT + dv1 * PT + 16 * q);
                if (FULL) {
                    const s16x4 v0l = *(const LAS s16x4*)(IM + IMG_VT + dv0 * PT + 8 * q), v0h = *(const LAS s16x4*)(IM + IMG_VT + dv0 * PT + 32 + 8 * q);
                    const s16x4 v1l = *(const LAS s16x4*)(IM + IMG_VT + dv1 * PT + 8 * q), v1h = *(const LAS s16x4*)(IM + IMG_VT + dv1 * PT + 32 + 8 * q);
                    const bf16x8 vp0 = __builtin_shufflevector(v0l, v0h, 0, 1, 2, 3, 4, 5, 6, 7), vp1 = __builtin_shufflevector(v1l, v1h, 0, 1, 2, 3, 4, 5, 6, 7);
                    const f32x4 z4 = (f32x4){0.f, 0.f, 0.f, 0.f};
                    f32x4 O00 = __builtin_amdgcn_mfma_f32_16x16x32_bf16(__builtin_bit_cast(bf16x8, pa0), vp0, z4, 0, 0, 0);
                    f32x4 O01 = __builtin_amdgcn_mfma_f32_16x16x32_bf16(__builtin_bit_cast(bf16x8, pa1), vp0, z4, 0, 0, 0);
                    f32x4 O10 = __builtin_amdgcn_mfma_f32_16x16x32_bf16(__builtin_bit_cast(bf16x8, pa0), vp1, z4, 0, 0, 0);
                    f32x4 O11 = __builtin_amdgcn_mfma_f32_16x16x32_bf16(__builtin_bit_cast(bf16x8, pa1), vp1, z4, 0, 0, 0);
#pragma unroll
                    for (int ks = 0; ks < 4; ++ks) {
                        const f32x4 e0 = *(const LAS f32x4*)(IM + IMG_ER + (32 * ks + 4 * q) * 4), e1 = *(const LAS f32x4*)(IM + IMG_ER + (32 * ks + 16 + 4 * q) * 4);
                        const s16x4 a0l = *(const LAS s16x4*)(IM + IMG_QE + i * PQ + (32 * ks + 4 * q) * 2), a0h = *(const LAS s16x4*)(IM + IMG_QE + i * PQ + (32 * ks + 16 + 4 * q) * 2);
                        const s16x4 a1l = *(const LAS s16x4*)(IM + IMG_QE + (16 + i) * PQ + (32 * ks + 4 * q) * 2), a1h = *(const LAS s16x4*)(IM + IMG_QE + (16 + i) * PQ + (32 * ks + 16 + 4 * q) * 2);
                        const bf16x8 qa0 = __builtin_shufflevector(a0l, a0h, 0, 1, 2, 3, 4, 5, 6, 7), qa1 = __builtin_shufflevector(a1l, a1h, 0, 1, 2, 3, 4, 5, 6, 7);
                        const f32x4 s00 = Sacc[0][2 * ks] * e0, s01 = Sacc[0][2 * ks + 1] * e1, s10 = Sacc[1][2 * ks] * e0, s11 = Sacc[1][2 * ks + 1] * e1;
                        v4u sb0, sb1; sb0.x = pk2(s00[0], s00[1]); sb0.y = pk2(s00[2], s00[3]); sb0.z = pk2(s01[0], s01[1]); sb0.w = pk2(s01[2], s01[3]);
                        sb1.x = pk2(s10[0], s10[1]); sb1.y = pk2(s10[2], s10[3]); sb1.z = pk2(s11[0], s11[1]); sb1.w = pk2(s11[2], s11[3]);
                        O00 = __builtin_amdgcn_mfma_f32_16x16x32_bf16(qa0, __builtin_bit_cast(bf16x8, sb0), O00, 0, 0, 0);
                        O01 = __builtin_amdgcn_mfma_f32_16x16x32_bf16(qa1, __builtin_bit_cast(bf16x8, sb0), O01, 0, 0, 0);
                        O10 = __builtin_amdgcn_mfma_f32_16x16x32_bf16(qa0, __builtin_bit_cast(bf16x8, sb1), O10, 0, 0, 0);
                        O11 = __builtin_amdgcn_mfma_f32_16x16x32_bf16(qa1, __builtin_bit_cast(bf16x8, sb1), O11, 0, 0, 0);
                    }
                    LAS unsigned char* OBw = L + L_OB0 + ((s - 1) & 1) * (32 * POB);
#pragma unroll
                    for (int r = 0; r < 4; ++r) { ((LAS float*)(OBw + (4 * q + r) * POB))[dv0] = O00[r]; ((LAS float*)(OBw + (16 + 4 * q + r) * POB))[dv0] = O01[r];
                                                  ((LAS float*)(OBw + (4 * q + r) * POB))[dv1] = O10[r]; ((LAS float*)(OBw + (16 + 4 * q + r) * POB))[dv1] = O11[r]; }
                }
#pragma unroll
                for (int dt = 0; dt < 8; ++dt) {
                    const f32x4 dd = *(const LAS f32x4*)(IM + IMG_DEC + (16 * dt + 4 * q) * 4);
                    const bf16x8 ka = *(const LAS bf16x8*)(IM + IMG_K2T + (16 * dt + i) * PT + 16 * q);
                    Sacc[0][dt] = __builtin_amdgcn_mfma_f32_16x16x32_bf16(ka, vnat0, dd * Sacc[0][dt], 0, 0, 0);
                    Sacc[1][dt] = __builtin_amdgcn_mfma_f32_16x16x32_bf16(ka, vnat1, dd * Sacc[1][dt], 0, 0, 0);
                }
            }
            WG_BAR();
        }
        if (it.u_out) {
#pragma unroll
            for (int sl = 0; sl < 2; ++sl)
#pragma unroll
                for (int dt = 0; dt < 8; ++dt) *(f32x4*)(it.u_out + ((size_t)(sl * 8 + dt) * 256 + wb * 64 + lane) * 4) = Sacc[sl][dt];
        }
        if (it.s_out) {
#pragma unroll
            for (int sl = 0; sl < 2; ++sl)
#pragma unroll
                for (int dt = 0; dt < 8; ++dt)
#pragma unroll
                    for (int r = 0; r < 4; ++r) it.s_out[(size_t)(16 * dt + 4 * q + r) * DV + 32 * wb + 16 * sl + i] = Sacc[sl][dt][r];
        }
    }
}

constexpr int DL_Q2 = 0, DL_K2 = 2048, DL_DEC = 4096, DL_V = 4608, DL_RED = 6656, DL_RED2 = 6784, DL_OP = 8192, DL_END = DL_OP + 16 * 4 * 128 * 4;
static_assert(2 * DL_END <= RING_BYTES, "decode lds map");
template <int NE>
__device__ __forceinline__ void decode_items(Frame& F, int idx0, int idx1) {
    int tid = F.tid, lane = F.lane; const int wv = F.wave;
    asm volatile("" : "+v"(tid), "+v"(lane));
    WG_BAR();
    const int v4i = tid & 31, slab = tid >> 5;
    f32x4 s4[NE][8]; float gav[NE], vraw[NE]; float lfv[NE][4], qfv[NE][4];
#pragma unroll
    for (int e = 0; e < NE; ++e) { const int idx = e ? idx1 : idx0; const float* S0 = F.state_hgrn + (size_t)idx * DK * DV;
#pragma unroll
        for (int dd = 0; dd < 8; ++dd) s4[e][dd] = *(const f32x4*)(S0 + (size_t)(8 * slab + dd) * DV + 4 * v4i); }
#pragma unroll
    for (int e = 0; e < NE; ++e) { const int idx = e ? idx1 : idx0, h = idx & 3, m0 = MP + (idx >> 2) * DT; const int t = tid >> 7, v = tid & 127;
        const size_t off = ((size_t)h * M + m0 + t) * 128 + v;
        vraw[e] = bflo((unsigned)F.V[off]); gav[e] = bflo((unsigned)F.GA[off]);
        if (tid < 128) {
#pragma unroll
            for (int tt = 0; tt < 4; ++tt) { lfv[e][tt] = (float)F.LOGF[((size_t)h * M + m0 + tt) * 128 + tid]; qfv[e][tt] = bflo((unsigned)F.QF[((size_t)h * M + m0 + tt) * 128 + tid]); }
        }
    }
    const float gnv = F.hgrn_norm_g[tid & 127];
#pragma unroll
    for (int e = 0; e < NE; ++e) { LAS unsigned char* L = F.lds + RING_OFF + e * DL_END;
        ((LAS float*)(L + DL_V))[tid] = vraw[e];
        if (tid < 128) {
            const int d = tid; float bb[4], kk[4];
            bb[0] = lfv[e][0]; bb[1] = bb[0] + lfv[e][1]; bb[2] = bb[1] + lfv[e][2]; bb[3] = bb[2] + lfv[e][3];
#pragma unroll
            for (int t = 0; t < 4; ++t) kk[t] = 1.f - fex2(lfv[e][t]);
            f32x4 q2, k2;
#pragma unroll
            for (int t = 0; t < 4; ++t) { q2[t] = qfv[e][t] * fex2(bb[t]); k2[t] = kk[t] * fex2(bb[3] - bb[t]); }
            *(LAS f32x4*)(L + DL_Q2 + d * 16) = q2; *(LAS f32x4*)(L + DL_K2 + d * 16) = k2; ((LAS float*)(L + DL_DEC))[d] = fex2(bb[3]);
            int pi = 0;
#pragma unroll
            for (int t = 0; t < 4; ++t)
#pragma unroll
                for (int s = 0; s <= t; ++s) { const float pv = wave_sum(qfv[e][t] * kk[s] * fex2(bb[t] - bb[s])); if (lane == 0) ((LAS float*)(L + DL_RED))[wv * 16 + pi] = pv; ++pi; }
        }
    }
    __syncthreads();
#pragma unroll
    for (int e = 0; e < NE; ++e) { LAS unsigned char* L = F.lds + RING_OFF + e * DL_END; const int idx = e ? idx1 : idx0; float* S1 = F.out + O_SHS + (size_t)idx * DK * DV;
        f32x4 V4[4], o[4];
#pragma unroll
        for (int t = 0; t < 4; ++t) { V4[t] = *(const LAS f32x4*)(L + DL_V + (t * 128 + 4 * v4i) * 4); o[t] = (f32x4){0.f, 0.f, 0.f, 0.f}; }
#pragma unroll
        for (int dd = 0; dd < 8; ++dd) {
            const int d = 8 * slab + dd;
            const f32x4 q2 = *(const LAS f32x4*)(L + DL_Q2 + d * 16), k2 = *(const LAS f32x4*)(L + DL_K2 + d * 16); const float dec = ((const LAS float*)(L + DL_DEC))[d];
#pragma unroll
            for (int t = 0; t < 4; ++t) o[t] += q2[t] * s4[e][dd];
            f32x4 sn = dec * s4[e][dd];
#pragma unroll
            for (int t = 0; t < 4; ++t) sn += k2[t] * V4[t];
            *(f32x4*)(S1 + (size_t)d * DV + 4 * v4i) = sn;
        }
#pragma unroll
        for (int t = 0; t < 4; ++t) *(LAS f32x4*)(L + DL_OP + ((slab * 4 + t) * 128 + 4 * v4i) * 4) = o[t];
    }
    __syncthreads();
    const int t = tid >> 7, v = tid & 127;
    float ov[NE];
#pragma unroll
    for (int e = 0; e < NE; ++e) { LAS unsigned char* L = F.lds + RING_OFF + e * DL_END;
        float o = 0.f;
#pragma unroll
        for (int sb = 0; sb < 16; ++sb) o += ((const LAS float*)(L + DL_OP))[(sb * 4 + t) * 128 + v];
        const LAS float* R = (const LAS float*)(L + DL_RED);
#pragma unroll
        for (int s = 0; s < 4; ++s) if (s <= t) { const int pi = (t * (t + 1)) / 2 + s; o += (R[pi] + R[16 + pi]) * ((const LAS float*)(L + DL_V))[s * 128 + v]; }
        ov[e] = o;
        const float ssw = wave_sum(o * o);
        if (lane == 0) ((LAS float*)(L + DL_RED2))[wv] = ssw;
    }
    __syncthreads();
#pragma unroll
    for (int e = 0; e < NE; ++e) { LAS unsigned char* L = F.lds + RING_OFF + e * DL_END; const int idx = e ? idx1 : idx0, h = idx & 3, m0 = MP + (idx >> 2) * DT;
        const float ss = ((const LAS float*)(L + DL_RED2))[2 * t] + ((const LAS float*)(L + DL_RED2))[2 * t + 1];
        const float rstd = __builtin_amdgcn_rsqf(ss * (1.f / 128.f) + EPS);
        F.OY[(size_t)(m0 + t) * 1024 + h * 128 + v] = (bf16)f2bf(ov[e] * rstd * gnv * gav[e]);
    }
}

constexpr int XL_P = LDSCTL_OFF + 1024, XL_S = XL_P + 4096, XL_FLAG = XL_S + 1024;
static_assert(XL_FLAG + 64 <= LDS_BYTES, "exchange scratch");
#define TAIL_SPIN_CAP (1u << 22)
struct OrderTail : pg8::TileOrder {
    const char *OYp, *Wab, *MGp, *Wout; gu32* cnt1;
    int t0, stride, count, kind2;
    int xt, xh;
    __device__ __forceinline__ bool next(int i, pg8::Unit& u) const {
        if (kind2) { if (i) return false; u.kind = 2; u.pm = t0 >> 2; u.pn = t0 & 3; u.half = xh >= 0; u.r0 = u.pm * 256 + (xh > 0 ? 128 : 0); return true; }
        if (i < count) { const int t = t0 + stride * i; u.kind = 1; u.pm = t >> 2; u.pn = t & 3; u.half = 0; u.r0 = u.pm * 256; return true; }
        if (i == count && xt >= 0) { u.kind = 1; u.pm = xt >> 2; u.pn = xt & 3; u.half = 1; u.r0 = u.pm * 256 + xh * 128; return true; }
        return false; }
    __device__ __forceinline__ const char* opA(const pg8::Unit& u) const { return (u.kind == 2 ? MGp : OYp) + (size_t)u.r0 * 2048; }
    __device__ __forceinline__ const char* opB(const pg8::Unit& u) const { return (u.kind == 2 ? Wout : Wab) + (size_t)u.pn * (256 * 2048); }
    __device__ __forceinline__ int nt(const pg8::Unit&) const { return 16; }
    __device__ __forceinline__ int mid_at(const pg8::Unit& u) const { return u.kind == 1 ? 8 : -1; }
    __device__ __forceinline__ void done(const pg8::Unit& u, int lane) const {
        if (u.kind == 1) { asm volatile("s_waitcnt vmcnt(0)" ::: "memory"); if (lane == 0) __hip_atomic_fetch_add(cnt1 + 64 * u.pm, u.half ? 1u : 2u, RLX_AGENT); }
    }
};
__device__ __forceinline__ void store16_sc1(const void* p, pg8::u32x4 v) { asm volatile("global_store_dwordx4 %0, %1, off sc1\n\ts_nop 1" :: "v"(p), "v"(v) : "memory"); }
struct EpiTail {
    static constexpr bool PERM = true, AFTER_DRAIN = false, HAS_MID = true;
    const bf16 *RA, *GBm; bf16* MG;
    const float *xp, *xs, *fg; float* out; float* xbuf; gu32* cnt2; LAS unsigned char* lds;
    __device__ __forceinline__ void mid(f32x4 (&acc)[2][2][4][2], const pg8::Unit& u, int wr, int wc, int fr, int fq) const {
        asm volatile("" : "+v"(fr), "+v"(fq));
        const int row0 = u.r0 + wr * 64 + fr, col0 = u.pn * 256 + wc * 32 + 8 * fq, nai = u.half ? 1 : 2;
        v4u rq[2][4][2];
#pragma unroll
        for (int ai = 0; ai < 2; ++ai) if (ai < nai)
#pragma unroll
            for (int m = 0; m < 4; ++m)
#pragma unroll
                for (int bj = 0; bj < 2; ++bj) rq[ai][m][bj] = *(const GAS v4u*)(RA + (size_t)(row0 + ai * 128 + m * 16) * 1024 + col0 + bj * 128);
        __builtin_amdgcn_sched_barrier(0);
#pragma unroll
        for (int ai = 0; ai < 2; ++ai) if (ai < nai)
#pragma unroll
            for (int m = 0; m < 4; ++m)
#pragma unroll
                for (int bj = 0; bj < 2; ++bj) { const v4u g = rq[ai][m][bj];
                    acc[ai][bj][m][0][0] *= bflo(g.x); acc[ai][bj][m][0][1] *= bfhi(g.x); acc[ai][bj][m][0][2] *= bflo(g.y); acc[ai][bj][m][0][3] *= bfhi(g.y);
                    acc[ai][bj][m][1][0] *= bflo(g.z); acc[ai][bj][m][1][1] *= bfhi(g.z); acc[ai][bj][m][1][2] *= bflo(g.w); acc[ai][bj][m][1][3] *= bfhi(g.w); }
        __builtin_amdgcn_sched_barrier(0);
    }
    __device__ __forceinline__ void operator()(const f32x4 (&acc)[2][2][4][2], const pg8::Unit& u, int wr, int wc, int fr, int fq, int wid, int lane) const {
        asm volatile("" : "+v"(fr), "+v"(fq));
        const int row0 = u.r0 + wr * 64 + fr, col0 = u.pn * 256 + wc * 32 + 8 * fq, nai = u.half ? 1 : 2;
        if (u.kind < 2) {
            v4u gq[2][4][2];
#pragma unroll
            for (int ai = 0; ai < 2; ++ai) if (ai < nai)
#pragma unroll
                for (int m = 0; m < 4; ++m)
#pragma unroll
                    for (int bj = 0; bj < 2; ++bj) gq[ai][m][bj] = *(const GAS v4u*)(GBm + (size_t)(row0 + ai * 128 + m * 16) * 1024 + col0 + bj * 128);
            __builtin_amdgcn_sched_barrier(0);
#pragma unroll
            for (int ai = 0; ai < 2; ++ai) if (ai < nai)
#pragma unroll
                for (int m = 0; m < 4; ++m)
#pragma unroll
                    for (int bj = 0; bj < 2; ++bj) { const size_t off = (size_t)(row0 + ai * 128 + m * 16) * 1024 + col0 + bj * 128;
                        const v4u g = gq[ai][m][bj]; const f32x4 v0 = acc[ai][bj][m][0], v1 = acc[ai][bj][m][1];
                        pg8::u32x4 w; w.x = pk2(v0[0] * bflo(g.x), v0[1] * bfhi(g.x)); w.y = pk2(v0[2] * bflo(g.y), v0[3] * bfhi(g.y)); w.z = pk2(v1[0] * bflo(g.z), v1[1] * bfhi(g.z)); w.w = pk2(v1[2] * bflo(g.w), v1[3] * bfhi(g.w));
                        store16_sc1(MG + off, w); }
            return;
        }
        f32x4 o[2][2][4][2];
        LAS float* P = (LAS float*)(lds + XL_P); LAS float* S = (LAS float*)(lds + XL_S);
#pragma unroll
        for (int ai = 0; ai < 2; ++ai) if (ai < nai) {
            f32x4 xq[4][2][2];
#pragma unroll
            for (int m = 0; m < 4; ++m) { const int row = row0 + ai * 128 + m * 16;
                const float* xr = (row < MP ? xp + (size_t)row * D : xs + (size_t)(row - MP) * D) + col0;
#pragma unroll
                for (int bj = 0; bj < 2; ++bj)
#pragma unroll
                    for (int n = 0; n < 2; ++n) xq[m][bj][n] = *(const f32x4*)(xr + bj * 128 + n * 4); }
            __builtin_amdgcn_sched_barrier(0);
#pragma unroll
            for (int m = 0; m < 4; ++m) { float ss = 0.f;
#pragma unroll
                for (int bj = 0; bj < 2; ++bj)
#pragma unroll
                    for (int n = 0; n < 2; ++n) { const f32x4 v = xq[m][bj][n] + acc[ai][bj][m][n]; o[ai][bj][m][n] = v; ss += (v.x * v.x + v.y * v.y) + (v.z * v.z + v.w * v.w); }
                ss += __shfl_xor(ss, 16); ss += __shfl_xor(ss, 32);
                if (fq == 0) P[(ai * 128 + wr * 64 + m * 16 + fr) * 4 + wc] = ss; }
        }
        asm volatile("s_waitcnt lgkmcnt(0)" ::: "memory"); __builtin_amdgcn_s_barrier(); asm volatile("" ::: "memory");
        const int prow = wid * 32 + (lane & 31); const bool pub = lane < 32 && prow < nai * 128;
        gu32* const cw = cnt2 + (u.r0 >> 7) * 32;
        if (pub) { const f32x4 p = *(const LAS f32x4*)(P + prow * 4);
            __hip_atomic_store((gu32*)xbuf + ((size_t)(u.r0 + prow) * 4 + u.pn), __builtin_bit_cast(unsigned, (p.x + p.y) + (p.z + p.w)), RLX_AGENT); }
        asm volatile("s_waitcnt vmcnt(0)" ::: "memory");
        if (lane == 0) __hip_atomic_fetch_add(cw, 1u, RLX_AGENT);
        if (wid == 0) { unsigned sp = 0;
            while ((unsigned)__builtin_amdgcn_readfirstlane(__hip_atomic_load(cw, RLX_AGENT)) < 32u) { __builtin_amdgcn_s_sleep(2); if (++sp > TAIL_SPIN_CAP) break; }
            __builtin_amdgcn_fence(__ATOMIC_ACQUIRE, "agent"); }
        asm volatile("s_waitcnt vmcnt(0) lgkmcnt(0)" ::: "memory"); __builtin_amdgcn_s_barrier(); asm volatile("" ::: "memory");
        if (pub) { gu32* sl = (gu32*)xbuf + (size_t)(u.r0 + prow) * 4; float t = 0.f;
#pragma unroll
            for (int k = 0; k < 4; ++k) t += __builtin_bit_cast(float, __hip_atomic_load(sl + k, RLX_AGENT));
            S[prow] = __builtin_amdgcn_rsqf(t * (1.f / D) + EPS); }
        asm volatile("s_waitcnt lgkmcnt(0)" ::: "memory"); __builtin_amdgcn_s_barrier(); asm volatile("" ::: "memory");
        f32x4 gv[2][2];
#pragma unroll
        for (int bj = 0; bj < 2; ++bj)
#pragma unroll
            for (int n = 0; n < 2; ++n) gv[bj][n] = *(const f32x4*)(fg + col0 + bj * 128 + n * 4);
#pragma unroll
        for (int ai = 0; ai < 2; ++ai) if (ai < nai)
#pragma unroll
            for (int m = 0; m < 4; ++m) { const int r = ai * 128 + wr * 64 + m * 16 + fr; const float rstd = S[r]; float* orow = out + (size_t)(u.r0 + r) * D + col0;
#pragma unroll
                for (int bj = 0; bj < 2; ++bj)
#pragma unroll
                    for (int n = 0; n < 2; ++n) *(f32x4*)(orow + bj * 128 + n * 4) = o[ai][bj][m][n] * rstd * gv[bj][n]; }
    }
};
__device__ __forceinline__ void wait_panel(gu32* cnt1, int pm, int wave) {
    if (wave == 0) { unsigned sp = 0;
        while ((unsigned)__builtin_amdgcn_readfirstlane(__hip_atomic_load(cnt1 + 64 * pm, RLX_AGENT)) < 64u) { __builtin_amdgcn_s_sleep(2); if (++sp > TAIL_SPIN_CAP) break; }
        __builtin_amdgcn_fence(__ATOMIC_ACQUIRE, "agent"); asm volatile("s_waitcnt vmcnt(0)" ::: "memory"); }
    __syncthreads();
}

struct Args { const float* in[14]; float* out; unsigned char* ws; int ph_lo, ph_hi, li, pad; };
__global__ void __launch_bounds__(NWAVES * 64, 2) hgrn_pool_fwd(Args args) {
    extern __shared__ __attribute__((aligned(16))) unsigned char lds[];
    Frame F;
    F.lds = (LAS unsigned char*)lds;
    F.MISC = (volatile LAS unsigned*)(F.lds + MISC_OFF);
    F.tid = threadIdx.x; F.lane = F.tid & 63; F.wave = __builtin_amdgcn_readfirstlane(F.tid >> 6);
    F.G = gridDim.x;
    unsigned char* ws = args.ws;
    F.ctl = (gu32*)(ws + WS_CTL);
    F.x_prompt = args.in[0]; F.x_sample = args.in[1]; F.state_hgrn = args.in[2]; F.state_pool = args.in[3]; F.norm_g = args.in[4]; F.w_in = args.in[5]; F.lb_logits = args.in[6];
    F.hgrn_norm_g = args.in[7]; F.w_proj_a = args.in[8]; F.w_pool = args.in[9]; F.pool_scale = args.in[10]; F.w_proj_b = args.in[11]; F.w_out = args.in[12]; F.final_norm_g = args.in[13];
    F.out = args.out;
    F.WinT = (bf16*)(ws + WS_WIN); F.WabT = (bf16*)(ws + WS_WA); F.WoutT = (bf16*)(ws + WS_WOUT); F.WpT = (bf16*)(ws + WS_WP);
    F.XN = (bf16*)(ws + WS_XN); F.QF = (bf16*)(ws + WS_QF); F.V = (bf16*)(ws + WS_V); F.GA = (bf16*)(ws + WS_GA); F.U = (bf16*)(ws + WS_U); F.GB = (bf16*)(ws + WS_GB);
    F.MA = (bf16*)(ws + WS_MA); F.MB = (bf16*)(ws + WS_MB); F.OY = (bf16*)(ws + WS_OY); F.MG = (bf16*)(ws + WS_MG);
    F.LOGF = (f16*)(ws + WS_LOGF); F.PART = (float*)(ws + WS_PART); F.DTOT = (float*)(ws + WS_DTOT); F.UWS = (float*)(ws + WS_UWS); F.SUF = (float*)(ws + WS_SUF);
    for (int u = F.tid; u < (LDS_BYTES - LDSCTL_OFF) / 4; u += NWAVES * 64) ((LAS unsigned*)(F.lds + LDSCTL_OFF))[u] = 0u;
    __syncthreads();
    XcdBarrier bar; bar.bar = (unsigned*)(F.ctl + CW_BAR); bar.x = 0; bar.st = nullptr;
    if (N_LAUNCHES != PER_PHASE) bar = xcd_barrier_post((unsigned*)(F.ctl + CW_BAR), F.MISC + 8);
#define GRID_BAR(seam) do { if (N_LAUNCHES == PER_PHASE) { if (F.tid == 0) __hip_atomic_store(F.ctl + CW_TMO, 0xBADBA0u | (unsigned)(seam), RLX_AGENT); } else { xcd_barrier(bar); } } while (0)
    const int lo = args.ph_lo, hi = args.ph_hi;
#define IN(k) (lo <= (k) && (k) < hi)
#define BOTH(k) (IN(k) && IN((k) + 1))

    if (IN(0)) { p0_prologue(F); if (BOTH(0)) GRID_BAR(0); }

    if (IN(1)) {
        pg8::OrderSingle S; S.init(M, DIN, F.G, (int)blockIdx.x); S.A = (const char*)F.XN; S.Bt = (const char*)F.WinT; S.tstep = (size_t)256 * D * 2; S.ntiles = D / 64;
        S.split = (F.G == 256 && S.nwg % F.G != 0 && (S.nwg % F.G) * 2 <= F.G) ? 1 : 0;
        EpiZ E{F.QF, F.V, F.GA, F.U, F.GB, F.MA, F.MB, F.LOGF, F.lb_logits, F.out + O_SPP, F.out + O_SPS};
        pg8::gemm_phase<EpiZ, pg8::OrderSingle, PG8_ALIGN, PG8_SP2>(F.lds + RING_OFF, D, S, E);
        if (BOTH(1)) GRID_BAR(1);
    }

    if (IN(2)) {
        constexpr int N_LOC = NB * NH * (NSUP - 1), N_PS = MS / 64, N_DEC = DB * NH, N_ALL = N_LOC + N_PS + N_DEC;
        for (int w = blockIdx.x; w < N_ALL; w += F.G) {
            if (w >= N_LOC && w < N_LOC + N_PS) pool_item(F, MP / 64 + (w - N_LOC));
            else if (w < N_LOC) {
                const int seq = w / (NSUP - 1), j = w % (NSUP - 1), b = seq >> 2, h = seq & 3;
                HgrnItem it; it.m0 = b * T + j * (CH * SCH); it.nchunks = SCH; it.h = h; it.s_start = nullptr; it.s_out = nullptr;
                it.u_out = F.UWS + (size_t)(seq * NSUP + j) * UWS_ITEM; it.d_out = F.DTOT + (size_t)(seq * NSUP + j) * 128;
                hgrn_pipe<false>(F, it);
            }
        }
        {
            constexpr int NB0 = N_LOC + N_PS;
            int d = (int)blockIdx.x; while (d < NB0) d += F.G; d -= NB0;
            for (; d < N_DEC; d += 2 * F.G) { if (d + F.G < N_DEC) decode_items<2>(F, d, d + F.G); else decode_items<1>(F, d, d); }
        }
        __syncthreads();
        if (BOTH(2)) GRID_BAR(2);
    }

    if (IN(3)) {
        for (int gt = blockIdx.x * (NWAVES * 64) + F.tid; gt < NB * NH * 4096; gt += F.G * NWAVES * 64) {
            const int seq = gt >> 12, f = gt & 4095, dtq = 16 * ((f >> 8) & 7) + 4 * ((f >> 4) & 3);
            f32x4 u[NSUP - 1], dd[NSUP - 1];
#pragma unroll
            for (int j = 0; j < NSUP - 1; ++j) { u[j] = *(const f32x4*)(F.UWS + (size_t)(seq * NSUP + j) * UWS_ITEM + (size_t)f * 4); dd[j] = *(const f32x4*)(F.DTOT + (size_t)(seq * NSUP + j) * 128 + dtq); }
            f32x4 S = (f32x4){0.f, 0.f, 0.f, 0.f};
#pragma unroll
            for (int j = 0; j < NSUP - 1; ++j) { S = dd[j] * S + u[j]; *(f32x4*)(F.UWS + (size_t)(seq * NSUP + j + 1) * UWS_ITEM + (size_t)f * 4) = S; }
        }
        {
            const int ln = (((int)blockIdx.x >> 3) & 31) * 32 + (F.tid & 31);
            if (F.tid < 32) { const unsigned v = *(const volatile unsigned*)((const char*)F.WpT + (size_t)ln * 128); asm volatile("" :: "v"(v)); }
        }
        if (BOTH(3)) GRID_BAR(3);
    }

    if (IN(4)) {
        for (int w = blockIdx.x; w < MP / 64; w += F.G) pool_item(F, w);
        for (int w = blockIdx.x; w < NB * NH * NSUP; w += F.G) {
            const int seq = w >> 3, j = w & 7, b = seq >> 2, h = seq & 3;
            HgrnItem it; it.m0 = b * T + j * (CH * SCH); it.nchunks = SCH; it.h = h; it.s_start = j ? F.UWS + (size_t)(seq * NSUP + j) * UWS_ITEM : nullptr;
            it.s_out = (j == NSUP - 1) ? F.out + O_SHP + (size_t)seq * DK * DV : nullptr; it.u_out = nullptr; it.d_out = nullptr;
            hgrn_pipe<true>(F, it);
        }
        __syncthreads();
        if (BOTH(4)) GRID_BAR(4);
    }

    if (IN(5)) {
        const int c = (int)blockIdx.x; const bool g256 = F.G == 256;
        const int vc = g256 ? ((c & 7) * 32 + (c >> 3)) : c;
        OrderTail S; S.init(M, D, F.G, c); S.OYp = (const char*)F.OY; S.Wab = (const char*)F.WabT; S.MGp = (const char*)F.MG; S.Wout = (const char*)F.WoutT; S.cnt1 = F.ctl + CW_CNT1;
        EpiTail E{F.MA, F.MB, F.MG, F.x_prompt, F.x_sample, F.final_norm_g, F.out, F.PART, F.ctl + CW_CNT2, F.lds};
        constexpr int NTILE = (M / 256) * (D / 256);
        S.kind2 = 0; S.t0 = vc; S.stride = F.G; S.xt = -1; S.xh = 0;
        if (g256) { S.count = 1; if (vc < 16) { S.xt = 256 + (vc >> 1); S.xh = vc & 1; } }
        else S.count = vc < NTILE ? (NTILE - 1 - vc) / F.G + 1 : 0;
        pg8::gemm_phase<EpiTail, OrderTail, PG8_ALIGN, PG8_SP2>(F.lds + RING_OFF, D, S, E);
        S.kind2 = 1; S.count = 1; S.xt = -1; S.xh = -1;
        if (g256) {
            S.t0 = vc < 8 ? 256 + vc : vc - 8; wait_panel(F.ctl + CW_CNT1, S.t0 >> 2, F.wave); pg8::gemm_phase<EpiTail, OrderTail, PG8_ALIGN, PG8_SP2>(F.lds + RING_OFF, D, S, E);
            if (vc >= 16 && vc < 32) { S.t0 = 248 + ((vc - 16) >> 1); S.xh = vc & 1; wait_panel(F.ctl + CW_CNT1, S.t0 >> 2, F.wave); pg8::gemm_phase<EpiTail, OrderTail, PG8_ALIGN, PG8_SP2>(F.lds + RING_OFF, D, S, E); }
        } else {
            for (int t = c; t < NTILE; t += F.G) { S.t0 = t; wait_panel(F.ctl + CW_CNT1, t >> 2, F.wave); pg8::gemm_phase<EpiTail, OrderTail, PG8_ALIGN, PG8_SP2>(F.lds + RING_OFF, D, S, E); }
        }
    }
#undef IN
#undef BOTH
}

extern "C" void kernel_launch(void* const* d_in, const int* in_sizes, int n_in, void* d_out, int out_size, void* d_ws, size_t ws_size, hipStream_t stream) {
    static int grid = 0;
    if (grid == 0) {
        if (n_in != 14 || in_sizes[0] != MP * D || out_size != (int)O_END || ws_size < WS_END) {
            fprintf(stderr, "kernel_launch: unexpected shapes (n_in %d, in0 %d, out %d, ws %zu need %zu); nothing launched\n", n_in, n_in > 0 ? in_sizes[0] : -1, out_size, ws_size, (size_t)WS_END); grid = -1; return; }
        int dev = 0, cus = 0, per_cu = 0;
        if (hipGetDevice(&dev) != hipSuccess || hipDeviceGetAttribute(&cus, hipDeviceAttributeMultiprocessorCount, dev) != hipSuccess) { grid = -1; return; }
        if (hipFuncSetAttribute((const void*)hgrn_pool_fwd, hipFuncAttributeMaxDynamicSharedMemorySize, LDS_BYTES) != hipSuccess) { fprintf(stderr, "kernel_launch: hipFuncSetAttribute failed\n"); grid = -1; return; }
        if (hipOccupancyMaxActiveBlocksPerMultiprocessor(&per_cu, (const void*)hgrn_pool_fwd, NWAVES * 64, LDS_BYTES) != hipSuccess || per_cu < 1) {
            fprintf(stderr, "kernel_launch: occupancy query reports %d workgroups per CU; nothing launched\n", per_cu); (void)hipGetLastError(); grid = -1; return; }
        grid = cus;
    }
    if (grid < 0) return;
    if (hipMemsetAsync((char*)d_ws + WS_CTL, 0, CTL_ZERO_BYTES, stream) != hipSuccess) return;
    Args a{};
    for (int i = 0; i < 14; ++i) a.in[i] = (const float*)d_in[i];
    a.out = (float*)d_out; a.ws = (unsigned char*)d_ws;
    for (int li = 0; li < N_LAUNCHES; ++li) {
        a.ph_lo = (N_LAUNCHES == PER_PHASE) ? li : 0; a.ph_hi = (N_LAUNCHES == PER_PHASE) ? li + 1 : PER_PHASE; a.li = li;
        hipLaunchKernelGGL(hgrn_pool_fwd, dim3(grid), dim3(NWAVES * 64), LDS_BYTES, stream, a);
        const hipError_t le = hipPeekAtLastError();
        if (le != hipSuccess) { fprintf(stderr, "kernel_launch: launch %d failed: %s\n", li, hipGetErrorName(le)); break; }
    }
}
```

```cpp
#include <hip/hip_runtime.h>
#include <cstdio>
#include <cstdint>

#ifndef MK_N_LAUNCHES
#define MK_N_LAUNCHES 1
#endif

namespace pg8 {
#define PG8_LAS __attribute__((address_space(3)))
typedef unsigned short bf16_t;
typedef short bf16x8 __attribute__((ext_vector_type(8)));
typedef float f32x4 __attribute__((ext_vector_type(4)));
typedef unsigned u32x4 __attribute__((ext_vector_type(4)));
constexpr int BM = 256, BK = 64, HALF = 128, HTB = HALF * BK * 2  , STAGE_BYTES = 8 * HTB, NXCD = 8, WGM = 8;

__host__ __device__ __forceinline__ int lds_byte(int r, int c) { const int st = (r >> 4) * 2 + (c >> 5), rr = r & 15, cc = c & 31, ob = rr * 64 + cc * 2; return st * 1024 + (ob ^ (((ob >> 9) & 1) << 5)); }
__host__ __device__ __forceinline__ void stage_rc(int b, int& R, int& C) { const int st = b / 1024, sb = b % 1024, swz = sb ^ (((sb >> 9) & 1) << 5); R = (st >> 1) * 16 + swz / 64; C = (st & 1) * 32 + (swz % 64) / 2; }
__host__ __device__ __forceinline__ int perm32(int rho) { const int n = rho >> 4, i = rho & 15; return 8 * (i >> 2) + 4 * n + (i & 3); }

struct Unit { int pm, pn, kind, half, r0; };

struct TileOrder {
    int nM, nN, nwg, G, c;
    __host__ __device__ void init(int M, int N, int G_, int c_) { nM = M / BM; nN = N / BM; nwg = nM * nN; G = G_; c = c_; }
    __host__ __device__ bool tile(long L, int& pm, int& pn) const {
        if (L >= nwg) return false;
        int wgid = (int)L; { const int q = nwg / NXCD, r = nwg % NXCD, xcd = wgid % NXCD, off = wgid / NXCD; wgid = (xcd < r ? xcd * (q + 1) : r * (q + 1) + (xcd - r) * q) + off; }
        const int nig = WGM * nN, gid = wgid / nig, fm = gid * WGM, gsz = (nM - fm) < WGM ? (nM - fm) : WGM;
        pm = fm + ((wgid % nig) % gsz); pn = (wgid % nig) / gsz; return true;
    }
};
struct OrderSingle : TileOrder {
    const char* A; const char* Bt; size_t tstep;
    int split;
    __device__ __forceinline__ bool next(int i, Unit& u) const { u.kind = 0; u.half = 0;
        if (split && i >= nwg / G) { if (i > nwg / G || c >= 2 * (nwg % G)) return false;
            const int xcd = c % NXCD, j = c / NXCD, wl = (nwg / NXCD) * xcd + (nwg / NXCD - (nwg % G) / NXCD) + (j >> 1);
            const int nig = WGM * nN, gid = wl / nig, fm = gid * WGM, gsz = (nM - fm) < WGM ? (nM - fm) : WGM;
            u.pm = fm + ((wl % nig) % gsz); u.pn = (wl % nig) / gsz; u.half = 1; u.r0 = u.pm * BM + (j & 1) * HALF; return true; }
        const bool ok = tile((long)i * G + c, u.pm, u.pn); u.r0 = u.pm * BM; return ok; }
    __device__ __forceinline__ const char* opA(const Unit& u) const { return A + (size_t)u.r0 * (tstep / BM); }
    __device__ __forceinline__ const char* opB(const Unit& u) const { return Bt + (size_t)u.pn * tstep; }
    int ntiles;
    __device__ __forceinline__ int nt(const Unit&) const { return ntiles; }
    __device__ __forceinline__ void done(const Unit&, int) const {}
};
__device__ __forceinline__ unsigned cvt_pk_bf16(float lo, float hi) { unsigned r; asm volatile("v_cvt_pk_bf16_f32 %0, %1, %2" : "=v"(r) : "v"(lo), "v"(hi)); return r; }

template <class Epi, class Sched, bool ALIGN_EPI = false, bool SP2 = false>
__device__ __forceinline__ void gemm_phase(PG8_LAS unsigned char* lds, const int K, const Sched& S, const Epi& E) {
    int tid = threadIdx.x; asm volatile("" : "+v"(tid));
    const int wid = __builtin_amdgcn_readfirstlane(tid >> 6), lane = tid & 63, wr = wid >> 2, wc = wid & 3, fr = lane & 15, fq = lane >> 4;
    unsigned voffA[2], voffB[2];
#pragma unroll
    for (int i = 0; i < 2; ++i) { int R, C; stage_rc(tid * 16 + i * 8192, R, C); const int Rb = Epi::PERM ? ((R & ~31) + perm32(R & 31)) : R;
        voffA[i] = (unsigned)(R * K + C) * 2u; voffB[i] = (unsigned)(Rb * K + C) * 2u; }
    const size_t kstep = (size_t)(BK * 2);
    const size_t hstep = (size_t)HALF * K * 2;
    const unsigned ldsw = (unsigned)wid * 1024u;
    const int aoff = lds_byte(wr * 64 + fr, fq * 8), boff = lds_byte(wc * 32 + fr, fq * 8);
#define PG8_SA(b, h) (((b) * 2 + (h)) * HTB)
#define PG8_SB(b, h) ((4 + (b) * 2 + (h)) * HTB)
#define PG8_STAGE(bufoff, gbase, voff) do { _Pragma("unroll") for (int _i = 0; _i < 2; ++_i) \
        __builtin_amdgcn_global_load_lds((const unsigned*)((const char*)(gbase) + (voff)[_i]), (PG8_LAS unsigned*)(lds + (bufoff) + ldsw + _i * 8192), 16, 0, 0); } while (0)
#define PG8_LDA(dst, b, h) do { _Pragma("unroll") for (int m = 0; m < 4; ++m) _Pragma("unroll") for (int k = 0; k < 2; ++k) dst[m][k] = *(const PG8_LAS bf16x8*)(lds + PG8_SA(b, h) + aoff + m * 2048 + k * 1024); } while (0)
#define PG8_LDB(dst, b, h) do { _Pragma("unroll") for (int n = 0; n < 2; ++n) _Pragma("unroll") for (int k = 0; k < 2; ++k) dst[n][k] = *(const PG8_LAS bf16x8*)(lds + PG8_SB(b, h) + boff + n * 2048 + k * 1024); } while (0)
#define PG8_MMA(ai, bj, At, Bt) do { __builtin_amdgcn_s_setprio(1); _Pragma("unroll") for (int m = 0; m < 4; ++m) _Pragma("unroll") for (int n = 0; n < 2; ++n) _Pragma("unroll") for (int k = 0; k < 2; ++k) \
        acc[ai][bj][m][n] = __builtin_amdgcn_mfma_f32_16x16x32_bf16(Bt[n][k], At[m][k], acc[ai][bj][m][n], 0, 0, 0); __builtin_amdgcn_s_setprio(0); } while (0)
#define PG8_WAIT_V(n) asm volatile("s_waitcnt vmcnt(" #n ")" ::: "memory")
#define PG8_WAIT_L(n) asm volatile("s_waitcnt lgkmcnt(" #n ")" ::: "memory")
#define PG8_BAR __builtin_amdgcn_s_barrier()
#define PG8_SCHED __builtin_amdgcn_sched_barrier(0)
    Unit cur, nxt; int ui = 0;
    if (!S.next(0, cur)) return;
    f32x4 acc[2][2][4][2];
#pragma unroll
    for (int a = 0; a < 2; ++a)
#pragma unroll
        for (int b = 0; b < 2; ++b)
#pragma unroll
            for (int m = 0; m < 4; ++m)
#pragma unroll
                for (int n = 0; n < 2; ++n) acc[a][b][m][n] = (f32x4){0.f, 0.f, 0.f, 0.f};
    bf16x8 At[4][2], B0[2][2], B1[2][2];
    const char* cA = S.opA(cur); const char* cB = S.opB(cur);
    size_t chA = cur.half ? 0 : hstep;
    if constexpr (SP2) {
        PG8_STAGE(PG8_SB(0, 0), cB, voffB); PG8_STAGE(PG8_SB(0, 1), cB + hstep, voffB); PG8_STAGE(PG8_SA(0, 0), cA, voffA); PG8_STAGE(PG8_SA(0, 1), cA + chA, voffA);
        if (wr == 1) PG8_BAR;
        PG8_WAIT_V(2); PG8_BAR;
        PG8_STAGE(PG8_SB(1, 0), cB + kstep, voffB); PG8_STAGE(PG8_SA(1, 0), cA + kstep, voffA); PG8_STAGE(PG8_SB(1, 1), cB + hstep + kstep, voffB);
        PG8_WAIT_V(6); PG8_BAR;
    } else {
        PG8_STAGE(PG8_SB(0, 0), cB, voffB); PG8_STAGE(PG8_SA(0, 0), cA, voffA); PG8_STAGE(PG8_SB(0, 1), cB + hstep, voffB); PG8_STAGE(PG8_SA(0, 1), cA + chA, voffA);
        if (wr == 1) PG8_BAR;
        PG8_WAIT_V(4); PG8_BAR;
        PG8_STAGE(PG8_SB(1, 0), cB + kstep, voffB); PG8_STAGE(PG8_SA(1, 0), cA + kstep, voffA); PG8_STAGE(PG8_SB(1, 1), cB + hstep + kstep, voffB);
        PG8_WAIT_V(6); PG8_BAR;
    }
    for (;;) {
        const bool has_next = S.next(ui + 1, nxt);
        const char* nA = has_next ? S.opA(nxt) : cA; const char* nB = has_next ? S.opB(nxt) : cB;
        const size_t nhA = has_next ? (nxt.half ? 0 : hstep) : chA;
        const bool full = cur.half == 0;
        const int nt = S.nt(cur);
        for (int t = 0; t < nt; t += 2) {
            if constexpr (Epi::HAS_MID) { if (t == S.mid_at(cur)) E.mid(acc, cur, wr, wc, fr, fq); }
            const bool last = (t == nt - 2);
            const char* a1 = cA + (size_t)(t + 1) * kstep;
            const char* a2 = last ? nA : cA + (size_t)(t + 2) * kstep; const char* b2 = last ? nB : cB + (size_t)(t + 2) * kstep;
            const char* a3 = a2 + kstep; const char* b3 = b2 + kstep;
            const size_t h2 = last ? nhA : chA;
            if constexpr (SP2) {
            PG8_LDB(B0, 0, 0); PG8_LDB(B1, 0, 1); PG8_SCHED; PG8_LDA(At, 0, 0); PG8_STAGE(PG8_SA(1, 1), a1 + chA, voffA);
            PG8_WAIT_V(8); PG8_WAIT_L(0); PG8_BAR; PG8_MMA(0, 0, At, B0); PG8_MMA(0, 1, At, B1); PG8_BAR; PG8_SCHED;
            PG8_LDA(At, 0, 1); PG8_STAGE(PG8_SB(0, 0), b2, voffB); PG8_STAGE(PG8_SB(0, 1), b2 + hstep, voffB); PG8_STAGE(PG8_SA(0, 0), a2, voffA);
            PG8_WAIT_V(8); PG8_WAIT_L(0); PG8_BAR; if (full) { PG8_MMA(1, 0, At, B0); PG8_MMA(1, 1, At, B1); } PG8_BAR; PG8_SCHED;
            PG8_LDB(B0, 1, 0); PG8_LDB(B1, 1, 1); PG8_SCHED; PG8_LDA(At, 1, 0); PG8_STAGE(PG8_SA(0, 1), a2 + h2, voffA);
            PG8_WAIT_V(8); PG8_WAIT_L(0); PG8_BAR; PG8_MMA(0, 0, At, B0); PG8_MMA(0, 1, At, B1); PG8_BAR; PG8_SCHED;
            PG8_LDA(At, 1, 1); PG8_STAGE(PG8_SB(1, 0), b3, voffB); PG8_STAGE(PG8_SB(1, 1), b3 + hstep, voffB); PG8_STAGE(PG8_SA(1, 0), a3, voffA);
            PG8_WAIT_V(8); PG8_WAIT_L(0); PG8_BAR; if (full) { PG8_MMA(1, 0, At, B0); PG8_MMA(1, 1, At, B1); } PG8_BAR; PG8_SCHED;
            } else {
            PG8_LDB(B0, 0, 0); PG8_SCHED; PG8_LDA(At, 0, 0); PG8_STAGE(PG8_SA(1, 1), a1 + chA, voffA);
            PG8_WAIT_L(8); PG8_BAR; PG8_WAIT_L(0); PG8_MMA(0, 0, At, B0); PG8_BAR; PG8_SCHED;
            PG8_LDB(B1, 0, 1); PG8_STAGE(PG8_SB(0, 0), b2, voffB);
            PG8_BAR; PG8_WAIT_L(0); PG8_MMA(0, 1, At, B1); PG8_BAR;
            PG8_LDA(At, 0, 1); PG8_STAGE(PG8_SA(0, 0), a2, voffA);
            PG8_BAR; PG8_WAIT_L(0); if (full) PG8_MMA(1, 0, At, B0); PG8_BAR; PG8_SCHED;
            PG8_STAGE(PG8_SB(0, 1), b2 + hstep, voffB);
            PG8_WAIT_V(6); PG8_BAR; if (full) PG8_MMA(1, 1, At, B1); PG8_BAR;
            PG8_LDB(B0, 1, 0); PG8_SCHED; PG8_LDA(At, 1, 0); PG8_STAGE(PG8_SA(0, 1), a2 + h2, voffA);
            PG8_WAIT_L(8); PG8_BAR; PG8_WAIT_L(0); PG8_MMA(0, 0, At, B0); PG8_BAR; PG8_SCHED;
            PG8_LDB(B1, 1, 1); PG8_STAGE(PG8_SB(1, 0), b3, voffB);
            PG8_BAR; PG8_WAIT_L(0); PG8_MMA(0, 1, At, B1); PG8_BAR;
            PG8_LDA(At, 1, 1); PG8_STAGE(PG8_SA(1, 0), a3, voffA);
            PG8_BAR; PG8_WAIT_L(0); if (full) PG8_MMA(1, 0, At, B0); PG8_BAR; PG8_SCHED;
            PG8_STAGE(PG8_SB(1, 1), b3 + hstep, voffB);
            PG8_WAIT_V(6); PG8_BAR; if (full) PG8_MMA(1, 1, At, B1); PG8_BAR;
            }
        }
        if constexpr (ALIGN_EPI) { if (wr == 0) PG8_BAR; }
        E(acc, cur, wr, wc, fr, fq, wid, lane); S.done(cur, lane);
        if (!has_next) break;
#pragma unroll
        for (int a = 0; a < 2; ++a)
#pragma unroll
            for (int b = 0; b < 2; ++b)
#pragma unroll
                for (int m = 0; m < 4; ++m)
#pragma unroll
                    for (int n = 0; n < 2; ++n) acc[a][b][m][n] = (f32x4){0.f, 0.f, 0.f, 0.f};
        cur = nxt; cA = nA; cB = nB; chA = nhA; ++ui;
        if constexpr (ALIGN_EPI) { if (wr == 1) PG8_BAR; }
    }
    PG8_WAIT_V(0);
    if constexpr (!ALIGN_EPI) { if (wr == 0) PG8_BAR; }
    PG8_BAR;
#undef PG8_SA
#undef PG8_SB
#undef PG8_STAGE
#undef PG8_LDA
#undef PG8_LDB
#undef PG8_MMA
#undef PG8_WAIT_V
#undef PG8_WAIT_L
#undef PG8_BAR
#undef PG8_SCHED
}
}

#ifndef PG8_SP2
#define PG8_SP2 true
#endif
#ifndef PG8_ALIGN
#define PG8_ALIGN true
#endif

constexpr int NWAVES = 8;
constexpr int N_LAUNCHES = MK_N_LAUNCHES;
constexpr int PER_PHASE = 6;
constexpr int D = 1024, NB = 8, T = 2048, DB = 128, DT = 4, WA = 512, NH = 4, DK = 128, DV = 128, WB = 512, PB = 15, DIN = 5120;
constexpr int MP = NB * T, MS = DB * DT, M = MP + MS;
constexpr float EPS = 1e-6f;
constexpr int CH = 32;
constexpr int SCH = 8;
constexpr int NSUP = T / (CH * SCH);
static_assert(M % 256 == 0 && NSUP == 8, "shapes");
constexpr size_t O_YP = 0, O_YS = (size_t)MP * D, O_SHP = O_YS + (size_t)MS * D, O_SPP = O_SHP + (size_t)NB * NH * DK * DV,
                 O_SHS = O_SPP + (size_t)NB * PB * WB, O_SPS = O_SHS + (size_t)DB * NH * DK * DV, O_END = O_SPS + (size_t)DB * PB * WB;
static_assert(O_END == 27258880, "output size");

constexpr size_t MiB = 1u << 20;
constexpr size_t al1(size_t x) { return (x + MiB - 1) & ~(MiB - 1); }
constexpr size_t SZ_H = (size_t)M * 512 * 2, SZ_F = (size_t)M * 1024 * 2;
constexpr size_t WS_CTL = 0, CTL_ZERO_BYTES = 192 * 1024;
constexpr size_t WS_WIN = 2 * MiB;
constexpr size_t WS_WA = WS_WIN + 10 * MiB, WS_WOUT = WS_WA + 2 * MiB, WS_WP = WS_WOUT + 2 * MiB;
constexpr size_t WS_PART = WS_WP + MiB;
constexpr size_t WS_DTOT = WS_PART + 2 * MiB;
constexpr size_t WS_XN = WS_DTOT + MiB;
constexpr size_t WS_QF = WS_XN + al1(SZ_F);
constexpr size_t WS_LOGF = WS_QF + al1(SZ_H);
constexpr size_t WS_V = WS_LOGF + al1(SZ_H);
constexpr size_t WS_GA = WS_V + al1(SZ_H);
constexpr size_t WS_U = WS_GA + al1(SZ_H);
constexpr size_t WS_GB = WS_U + al1(SZ_H);
constexpr size_t WS_MA = WS_GB + al1(SZ_H);
constexpr size_t WS_MB = WS_MA + al1(SZ_F);
constexpr size_t WS_OY = WS_MB + al1(SZ_F);
constexpr size_t WS_MG = WS_OY + al1(SZ_F);
constexpr size_t UWS_ITEM = (size_t)DK * DV;
constexpr size_t WS_UWS = WS_MG + al1(SZ_F);
constexpr size_t WS_SUF = WS_UWS + (size_t)NB * NH * NSUP * UWS_ITEM * 4;
constexpr size_t WS_END = WS_SUF + MiB;
constexpr int CW_TMO = 0, CW_CODE = 1;
constexpr int CW_BAR = 4096;
constexpr int CW_CNT1 = 16384, CW_CNT2 = 16384 + 8192, CW_CNTS = 32768;
static_assert((CW_CNTS + 64 * NB * NH) * 4 <= (int)CTL_ZERO_BYTES && (CW_CNT2 + 8192) * 4 <= (int)CTL_ZERO_BYTES && (CW_BAR + 3456) * 4 <= (int)CTL_ZERO_BYTES, "control words inside the zeroed region");

constexpr int RING_OFF = 0, RING_BYTES = 131072;
constexpr int LDSCTL_OFF = RING_BYTES, MISC_OFF = LDSCTL_OFF + 320;
constexpr int LDS_BYTES = 147456;

#define GAS __attribute__((address_space(1)))
#define LAS __attribute__((address_space(3)))
typedef unsigned short bf16;
typedef unsigned v4u __attribute__((ext_vector_type(4)));
typedef unsigned v2u __attribute__((ext_vector_type(2)));
typedef float f32x4 __attribute__((ext_vector_type(4)));
typedef short bf16x8 __attribute__((ext_vector_type(8)));
typedef short s16x4 __attribute__((ext_vector_type(4)));
typedef GAS unsigned gu32;
typedef _Float16 f16;
typedef _Float16 f16v2 __attribute__((ext_vector_type(2)));
#define RLX_AGENT __ATOMIC_RELAXED, __HIP_MEMORY_SCOPE_AGENT
#define LDS_WAIT() asm volatile("s_waitcnt lgkmcnt(0)" ::: "memory")
#define VM_WAIT() asm volatile("s_waitcnt vmcnt(0)" ::: "memory")
#define WG_BAR() do { asm volatile("s_waitcnt lgkmcnt(0)" ::: "memory"); __builtin_amdgcn_s_barrier(); asm volatile("" ::: "memory"); } while (0)
__device__ __forceinline__ unsigned f2bf(float f) { unsigned u = __builtin_bit_cast(unsigned, f); return (u + 0x7fffu + ((u >> 16) & 1u)) >> 16; }
typedef __bf16 bf16v2 __attribute__((ext_vector_type(2)));
typedef float f32v2 __attribute__((ext_vector_type(2)));
__device__ __forceinline__ unsigned pk2(float lo, float hi) { const f32v2 v = {lo, hi}; return __builtin_bit_cast(unsigned, __builtin_convertvector(v, bf16v2)); }
__device__ __forceinline__ float bflo(unsigned w) { return __builtin_bit_cast(float, w << 16); }
__device__ __forceinline__ float bfhi(unsigned w) { return __builtin_bit_cast(float, w & 0xffff0000u); }
__device__ __forceinline__ float fexp(float x) { return __builtin_amdgcn_exp2f(x * 1.4426950408889634f); }
__device__ __forceinline__ float fsigm(float x) { return __builtin_amdgcn_rcpf(1.f + fexp(-x)); }
__device__ __forceinline__ float flog2(float x) { return __builtin_amdgcn_logf(x); }
__device__ __forceinline__ float fex2(float x) { return __builtin_amdgcn_exp2f(x); }

__device__ __forceinline__ void store16_sc1(const void* p, pg8::u32x4 v) { asm volatile("global_store_dwordx4 %0, %1, off sc1\n\ts_nop 1" :: "v"(p), "v"(v) : "memory"); }
__device__ __forceinline__ void store8_sc1(const void* p, v2u v) { asm volatile("global_store_dwordx2 %0, %1, off sc1\n\ts_nop 1" :: "v"(p), "v"(v) : "memory"); }

#define XB_TMO      128
#define XB_XCNT(j)  (256  + 64 * (j))
#define XB_XSUB(j)  (1280 + 64 * (j))
#define XB_XGEN(j)  (2304 + 64 * (j))
#define XB_TOP      3328
#define XB_TOPGEN   3392
#define XCD_BAR_WORDS 3456
#define XB_SPIN_CAP (1u << 18)
__device__ __forceinline__ unsigned xb_ld(unsigned* p)              { return __hip_atomic_load(p, __ATOMIC_RELAXED, __HIP_MEMORY_SCOPE_AGENT); }
__device__ __forceinline__ unsigned xb_add(unsigned* p, unsigned v) { return __hip_atomic_fetch_add(p, v, __ATOMIC_RELAXED, __HIP_MEMORY_SCOPE_AGENT); }
__device__ __forceinline__ unsigned xb_xcc_id() { return (unsigned)__builtin_amdgcn_s_getreg((3 << 11) | 20) & 0xFu; }
#define XB_SPIN(cond, bar) do { unsigned _sp = 0; while (cond) { __builtin_amdgcn_s_sleep(1); \
    if ((++_sp & 255u) == 0u) { if (xb_ld(&(bar)[XB_TMO])) break; if (_sp > XB_SPIN_CAP) { atomicAdd(&(bar)[XB_TMO], 1u); break; } } } } while (0)
struct XcdBarrier { unsigned* bar; unsigned x; volatile LAS unsigned* st; };
__device__ __forceinline__ XcdBarrier xcd_barrier_post(unsigned* bar, volatile LAS unsigned* st) {
    XcdBarrier b; b.bar = bar; b.x = xb_xcc_id(); b.st = st;
    if (threadIdx.x == 0) (void)xb_add(&bar[XB_XCNT(b.x)], 1u);
    return b;
}
__device__ __forceinline__ void xcd_barrier_complete(unsigned* bar, unsigned x, unsigned& nloc, unsigned& nx) {
    const unsigned G = gridDim.x * gridDim.y * gridDim.z;
    unsigned sum, cnt, mine, sp = 0u;
    for (;;) {
        sum = 0u; cnt = 0u; mine = 0u;
#pragma unroll
        for (unsigned j = 0; j < 16; ++j) { const unsigned c = xb_ld(&bar[XB_XCNT(j)]); sum += c; cnt += (c > 0u) ? 1u : 0u; mine = (j == x) ? c : mine; }
        if (sum == G) break;
        __builtin_amdgcn_s_sleep(1);
        if ((++sp & 255u) == 0u) { if (xb_ld(&bar[XB_TMO])) break; if (sp > XB_SPIN_CAP) { atomicAdd(&bar[XB_TMO], 1u); break; } }
    }
    nloc = mine > 0u ? mine : 1u; nx = cnt > 0u ? cnt : 1u;
}
__device__ __forceinline__ void xcd_barrier(const XcdBarrier& b) {
    asm volatile("s_waitcnt vmcnt(0)" ::: "memory");
    __syncthreads();
    if (threadIdx.x == 0) {
        unsigned* bar = b.bar;
        __builtin_amdgcn_s_waitcnt(0);
        unsigned nloc = b.st[0], nx = b.st[1];
        if (nloc == 0u) { xcd_barrier_complete(bar, b.x, nloc, nx); b.st[0] = nloc; b.st[1] = nx; }
        const unsigned old = xb_add(&bar[XB_XSUB(b.x)], 1u);
        const unsigned gen = old / nloc;
        if (old + 1u == (gen + 1u) * nloc) {
            __builtin_amdgcn_fence(__ATOMIC_RELEASE, "agent");
            asm volatile("s_waitcnt vmcnt(0)" ::: "memory");
            const unsigned og = xb_add(&bar[XB_TOP], 1u);
            const unsigned tg = og / nx;
            if (og + 1u == (tg + 1u) * nx) xb_add(&bar[XB_TOPGEN], 1u);
            else XB_SPIN(xb_ld(&bar[XB_TOPGEN]) == tg, bar);
            __builtin_amdgcn_fence(__ATOMIC_ACQUIRE, "agent");
            xb_add(&bar[XB_XGEN(b.x)], 1u);
            asm volatile("s_waitcnt vmcnt(0)" ::: "memory");
        } else {
            XB_SPIN(xb_ld(&bar[XB_XGEN(b.x)]) == gen, bar);
            __builtin_amdgcn_fence(__ATOMIC_ACQUIRE, "agent");
            asm volatile("s_waitcnt vmcnt(0)" ::: "memory");
        }
    }
    __syncthreads();
}

struct Frame {
    LAS unsigned char* lds;
    volatile LAS unsigned* MISC;
    gu32* ctl;
    int tid, lane, wave;
    int G;
    const float *x_prompt, *x_sample, *state_hgrn, *state_pool, *norm_g, *w_in, *lb_logits, *hgrn_norm_g, *w_proj_a, *w_pool, *pool_scale, *w_proj_b, *w_out, *final_norm_g;
    float* out;
    bf16 *WinT, *WabT, *WoutT, *WpT;
    bf16 *XN, *QF, *V, *GA, *U, *GB, *MA, *MB, *OY, *MG;
    f16* LOGF; float *PART, *DTOT, *UWS, *SUF;
};

__device__ __forceinline__ float wave_sum(float v) {
#pragma unroll
    for (int o = 1; o < 64; o <<= 1) v += __shfl_xor(v, o);
    return v;
}
__device__ __forceinline__ const float* xrow_ptr(const Frame& F, int m) { return m < MP ? F.x_prompt + (size_t)m * D : F.x_sample + (size_t)(m - MP) * D; }

__host__ __device__ __forceinline__ size_t hm_off(int m, int c) { return ((size_t)(c >> 7) * M + m) * 128 + (c & 127); }
__device__ __forceinline__ int win_row_of_col(int c) { if (c < 3072) return c; const int b = c >= 4096, a = c - (b ? 4096 : 3072); return 3072 + ((a >> 7) << 8) + (b << 7) + (a & 127); }
template <bool MAPROWS = false>
__device__ __forceinline__ void p0_transpose_item(const float* W, int K, int N, bf16* WT, int opitch, LAS float* scr, int item, int lane) {
    const int nblk = N / 32, kb = item / nblk, nb = item % nblk, k0 = 64 * kb, n0 = 32 * nb;
#pragma unroll 8
    for (int i = 0; i < 32; ++i) { const int kk = 2 * i + (lane >> 5); scr[kk * 33 + (lane & 31)] = W[(size_t)(k0 + kk) * N + n0 + (lane & 31)]; }
    LDS_WAIT(); asm volatile("" ::: "memory");
    const int c = lane & 7;
#pragma unroll
    for (int j = 0; j < 4; ++j) { const int n = (lane >> 3) + 8 * j; const LAS float* s = scr + (8 * c) * 33 + n;
        v4u o; o.x = pk2(s[0 * 33], s[1 * 33]); o.y = pk2(s[2 * 33], s[3 * 33]); o.z = pk2(s[4 * 33], s[5 * 33]); o.w = pk2(s[6 * 33], s[7 * 33]);
        *(GAS v4u*)(WT + (size_t)(MAPROWS ? win_row_of_col(n0 + n) : n0 + n) * opitch + k0 + 8 * c) = o; }
    LDS_WAIT(); asm volatile("" ::: "memory");
}
template <int NR>
__device__ __forceinline__ void rms_rows_to_bf16(const Frame& F, int m0, int mstride, const f32x4 (&g)[4]) {
    f32x4 v[NR][4];
#pragma unroll
    for (int r = 0; r < NR; ++r) { const GAS f32x4* xr = (const GAS f32x4*)xrow_ptr(F, m0 + r * mstride) + F.lane;
#pragma unroll
        for (int j = 0; j < 4; ++j) v[r][j] = xr[64 * j]; }
#pragma unroll
    for (int r = 0; r < NR; ++r) { float s = 0.f;
#pragma unroll
        for (int j = 0; j < 4; ++j) s += (v[r][j].x * v[r][j].x + v[r][j].y * v[r][j].y) + (v[r][j].z * v[r][j].z + v[r][j].w * v[r][j].w);
        const float rstd = __builtin_amdgcn_rsqf(wave_sum(s) * (1.f / D) + EPS);
        GAS unsigned long long* o8 = (GAS unsigned long long*)(F.XN + (size_t)(m0 + r * mstride) * D) + F.lane;
#pragma unroll
        for (int j = 0; j < 4; ++j) o8[64 * j] = (unsigned long long)pk2(v[r][j].x * rstd * g[j].x, v[r][j].y * rstd * g[j].y) | ((unsigned long long)pk2(v[r][j].z * rstd * g[j].z, v[r][j].w * rstd * g[j].w) << 32); }
}
__device__ __forceinline__ void p0_prologue(Frame& F) {
    LAS float* scr = (LAS float*)(F.lds + RING_OFF + F.wave * 16384);
    const int gw = blockIdx.x * NWAVES + F.wave, NGW = F.G * NWAVES;
    constexpr int I_IN = (D / 64) * (DIN / 32), I_A = (WA / 64) * (D / 32), I_B = (WB / 64) * (D / 32), I_O = (D / 64) * (D / 32), I_P = (128 / 64) * (128 / 32);
    constexpr int NITEMS = I_IN + I_A + I_B + I_O + 4 * I_P;
    for (int it = gw; it < NITEMS; it += NGW) {
        int r = it;
        if (r < I_IN) { p0_transpose_item<true>(F.w_in, D, DIN, F.WinT, D, scr, r, F.lane); continue; } r -= I_IN;
        if (r < I_A) { p0_transpose_item(F.w_proj_a, WA, D, F.WabT, 1024, scr, r, F.lane); continue; } r -= I_A;
        if (r < I_B) { p0_transpose_item(F.w_proj_b, WB, D, F.WabT + 512, 1024, scr, r, F.lane); continue; } r -= I_B;
        if (r < I_O) { p0_transpose_item(F.w_out, D, D, F.WoutT, D, scr, r, F.lane); continue; } r -= I_O;
        const int g = r / I_P; r -= g * I_P;
        p0_transpose_item(F.w_pool + (size_t)g * 128 * 128, 128, 128, F.WpT + (size_t)g * 128 * 128, 128, scr, r, F.lane);
    }
    {   f32x4 g[4];
#pragma unroll
        for (int j = 0; j < 4; ++j) g[j] = ((const GAS f32x4*)F.norm_g + F.lane)[64 * j];
        int m = gw;
        for (; m + 3 * NGW < M; m += 4 * NGW) rms_rows_to_bf16<4>(F, m, NGW, g);
        for (; m < M; m += NGW) rms_rows_to_bf16<1>(F, m, NGW, g);
    }
    for (int i = blockIdx.x * (NWAVES * 64) + F.tid; i < DB * (WB / 4); i += F.G * NWAVES * 64) {
        const int c4 = i % (WB / 4), b = i / (WB / 4), w = 2 << (c4 >> 5);
        const float* bp = F.state_pool + (size_t)b * PB * WB + c4 * 4;
        f32x4 r[PB];
#pragma unroll
        for (int j = 0; j < PB; ++j) r[j] = (j >= PB - (w - 1)) ? *(const f32x4*)(bp + (size_t)j * WB) : (f32x4){0.f, 0.f, 0.f, 0.f};
        f32x4 acc = (f32x4){0.f, 0.f, 0.f, 0.f};
#pragma unroll
        for (int n = 1; n <= PB; ++n) { acc += r[PB - n];
#pragma unroll
            for (int t = 0; t < 4; ++t) if (n == w - 1 - t) *(f32x4*)(F.SUF + ((size_t)(b * 4 + t)) * WB + c4 * 4) = acc; }
#pragma unroll
        for (int t = 0; t < 4; ++t) if (w - 1 - t <= 0) *(f32x4*)(F.SUF + ((size_t)(b * 4 + t)) * WB + c4 * 4) = (f32x4){0.f, 0.f, 0.f, 0.f};
    }
    float* sps = F.out + O_SPS;
    for (int i = blockIdx.x * (NWAVES * 64) + F.tid; i < DB * 11 * (WB / 4); i += F.G * NWAVES * 64) {
        const int c4 = i % (WB / 4), j = (i / (WB / 4)) % 11, b = i / ((WB / 4) * 11);
        *(f32x4*)(sps + ((size_t)b * PB + j) * WB + c4 * 4) = *(const f32x4*)(F.state_pool + ((size_t)b * PB + j + 4) * WB + c4 * 4);
    }
}

struct EpiZ {
    static constexpr bool PERM = true, AFTER_DRAIN = false, HAS_MID = false;
    bf16 *QF, *V, *GA, *U, *GB, *MA, *MB; f16* LOGF; const float* lb_logits; float* spp; float* sps;
    __device__ __forceinline__ void operator()(const f32x4 (&acc)[2][2][4][2], const pg8::Unit& u, int wr, int wc, int fr, int fq, int, int) const {
        const int row0 = u.r0 + wr * 64 + fr, cl0 = wc * 32 + 8 * fq;
        const int pn = u.pn, nai = u.half ? 1 : 2;
        if (pn >= 2 && pn < 4) {
            float lb[2][8];
#pragma unroll
            for (int bj = 0; bj < 2; ++bj) { const int c = (pn - 2) * 256 + bj * 128 + cl0;
#pragma unroll
                for (int j = 0; j < 8; ++j) lb[bj][j] = fsigm(lb_logits[c + j] - lb_logits[WA + c + j]); }
#pragma unroll
            for (int ai = 0; ai < 2; ++ai) if (ai < nai)
#pragma unroll
                for (int m = 0; m < 4; ++m) { const int row = row0 + ai * 128 + m * 16;
#pragma unroll
                    for (int bj = 0; bj < 2; ++bj) { const int c = (pn - 2) * 256 + bj * 128 + cl0; f32x4 o0, o1;
#pragma unroll
                        for (int j = 0; j < 4; ++j) { o0[j] = flog2(lb[bj][j] + (1.f - lb[bj][j]) * fsigm(acc[ai][bj][m][0][j]));
                                                      o1[j] = flog2(lb[bj][4 + j] + (1.f - lb[bj][4 + j]) * fsigm(acc[ai][bj][m][1][j])); }
                        v4u w; w.x = __builtin_bit_cast(unsigned, (f16v2){(f16)o0[0], (f16)o0[1]}); w.y = __builtin_bit_cast(unsigned, (f16v2){(f16)o0[2], (f16)o0[3]});
                        w.z = __builtin_bit_cast(unsigned, (f16v2){(f16)o1[0], (f16)o1[1]}); w.w = __builtin_bit_cast(unsigned, (f16v2){(f16)o1[2], (f16)o1[3]});
                        *(v4u*)(LOGF + hm_off(row, c)) = w; } }
            return;
        }
        if (pn >= 12) {
            const int c = ((pn - 12) >> 1) * 256 + ((pn - 12) & 1) * 128 + cl0;
#pragma unroll
            for (int ai = 0; ai < 2; ++ai) if (ai < nai)
#pragma unroll
                for (int m = 0; m < 4; ++m) { const int row = row0 + ai * 128 + m * 16; float rr[8], gg[8];
#pragma unroll
                    for (int n = 0; n < 2; ++n)
#pragma unroll
                        for (int j = 0; j < 4; ++j) { const float ea = fexp(-acc[ai][0][m][n][j]), eb = fexp(-acc[ai][1][m][n][j]); gg[4 * n + j] = __builtin_amdgcn_rcpf(1.f + eb); rr[4 * n + j] = (1.f + eb) * __builtin_amdgcn_rcpf(1.f + ea); }
                    pg8::u32x4 w; w.x = pg8::cvt_pk_bf16(rr[0], rr[1]); w.y = pg8::cvt_pk_bf16(rr[2], rr[3]); w.z = pg8::cvt_pk_bf16(rr[4], rr[5]); w.w = pg8::cvt_pk_bf16(rr[6], rr[7]);
                    *(pg8::u32x4*)(MA + (size_t)row * 1024 + c) = w;
                    w.x = pg8::cvt_pk_bf16(gg[0], gg[1]); w.y = pg8::cvt_pk_bf16(gg[2], gg[3]); w.z = pg8::cvt_pk_bf16(gg[4], gg[5]); w.w = pg8::cvt_pk_bf16(gg[6], gg[7]);
                    *(pg8::u32x4*)(MB + (size_t)row * 1024 + c) = w; }
            return;
        }
        bf16* base; int ct, mode; bool hm = true;
        if (pn < 2) { base = QF; ct = pn; mode = 2; }
        else if (pn < 6) { base = V; ct = pn - 4; mode = 0; }
        else if (pn < 8) { base = GA; ct = pn - 6; mode = 1; }
        else if (pn < 10) { base = U; ct = pn - 8; mode = 0; hm = false; }
        else { base = GB; ct = pn - 10; mode = 1; hm = false; }
        const float sc = mode == 2 ? 0.08838834764831845f : 1.f;
#pragma unroll
        for (int ai = 0; ai < 2; ++ai) if (ai < nai)
#pragma unroll
            for (int m = 0; m < 4; ++m) { const int row = row0 + ai * 128 + m * 16;
#pragma unroll
                for (int bj = 0; bj < 2; ++bj) { const int c = ct * 256 + bj * 128 + cl0;
                    f32x4 v0 = acc[ai][bj][m][0], v1 = acc[ai][bj][m][1];
                    if (mode != 0) {
#pragma unroll
                        for (int j = 0; j < 4; ++j) { v0[j] = v0[j] * fsigm(v0[j]) * sc; v1[j] = v1[j] * fsigm(v1[j]) * sc; }
                    }
                    pg8::u32x4 w; w.x = pg8::cvt_pk_bf16(v0[0], v0[1]); w.y = pg8::cvt_pk_bf16(v0[2], v0[3]); w.z = pg8::cvt_pk_bf16(v1[0], v1[1]); w.w = pg8::cvt_pk_bf16(v1[2], v1[3]);
                    *(pg8::u32x4*)(base + (hm ? hm_off(row, c) : (size_t)row * 512 + c)) = w;
                    if (pn >= 8 && pn < 10) {
                        float* dst = nullptr;
                        if (row >= MP) { const int sr = row - MP; dst = sps + ((size_t)(sr >> 2) * PB + 11 + (sr & 3)) * WB + c; }
                        else if ((row & (T - 1)) >= T - PB) dst = spp + ((size_t)(row >> 11) * PB + ((row & (T - 1)) - (T - PB))) * WB + c;
                        if (dst) { *(f32x4*)dst = acc[ai][bj][m][0]; *(f32x4*)(dst + 4) = acc[ai][bj][m][1]; }
                    }
                } }
    }
};

constexpr int PP = 1040;
__device__ __forceinline__ void unpack8(const v4u r, float (&x)[8]) { x[0] = bflo(r.x); x[1] = bfhi(r.x); x[2] = bflo(r.y); x[3] = bfhi(r.y); x[4] = bflo(r.z); x[5] = bfhi(r.z); x[6] = bflo(r.w); x[7] = bfhi(r.w); }
template <int W>
__device__ __forceinline__ void pool_rows_prompt(const Frame& F, int m0, LAS unsigned char* PA) {
    int tid_ = F.tid; asm volatile("" : "+v"(tid_));
    const int c8 = tid_ >> 3, t0 = 8 * (tid_ & 7), m = m0 + t0, tseq0 = m & (T - 1);
    v4u r[W + 7];
#pragma unroll
    for (int jj = 0; jj < W + 7; ++jj) { const int dt = jj - (W - 1);
        r[jj] = (tseq0 + dt) >= 0 ? *(const GAS v4u*)(F.U + (size_t)(m + dt) * 512 + c8 * 8) : (v4u){0u, 0u, 0u, 0u}; }
    float a[8], x[8];
#pragma unroll
    for (int j = 0; j < 8; ++j) a[j] = 0.f;
#pragma unroll
    for (int jj = 0; jj < W - 1; ++jj) { unpack8(r[jj], x);
#pragma unroll
        for (int j = 0; j < 8; ++j) a[j] += x[j]; }
#pragma unroll
    for (int i = 0; i < 8; ++i) {
        unpack8(r[W - 1 + i], x);
#pragma unroll
        for (int j = 0; j < 8; ++j) a[j] += x[j];
        const int pos = tseq0 + i; const float ic = 1.f / (float)((pos + 1) < W ? (pos + 1) : W);
        v4u o; o.x = pk2(a[0] * ic - x[0], a[1] * ic - x[1]); o.y = pk2(a[2] * ic - x[2], a[3] * ic - x[3]); o.z = pk2(a[4] * ic - x[4], a[5] * ic - x[5]); o.w = pk2(a[6] * ic - x[6], a[7] * ic - x[7]);
        *(LAS v4u*)(PA + (t0 + i) * PP + c8 * 16) = o;
        unpack8(r[i], x);
#pragma unroll
        for (int j = 0; j < 8; ++j) a[j] -= x[j];
    }
}
template <int W>
__device__ __forceinline__ void pool_rows_sample(const Frame& F, int m0, LAS unsigned char* PA) {
    int tid_ = F.tid; asm volatile("" : "+v"(tid_));
    const int c8 = tid_ >> 3, t0 = 8 * (tid_ & 7), m = m0 + t0, b0 = (m - MP) >> 2;
    v4u r[8];
#pragma unroll
    for (int i = 0; i < 8; ++i) r[i] = *(const GAS v4u*)(F.U + (size_t)(m + i) * 512 + c8 * 8);
    f32x4 s0[8], s1[8];
#pragma unroll
    for (int i = 0; i < 8; ++i) { const float* sp = F.SUF + ((size_t)((b0 + (i >> 2)) * 4 + (i & 3))) * WB + c8 * 8; s0[i] = *(const f32x4*)sp; s1[i] = *(const f32x4*)(sp + 4); }
#pragma unroll
    for (int i = 0; i < 8; ++i) {
        const int tq = i & 3;
        float a[8], x[8];
        a[0] = s0[i].x; a[1] = s0[i].y; a[2] = s0[i].z; a[3] = s0[i].w; a[4] = s1[i].x; a[5] = s1[i].y; a[6] = s1[i].z; a[7] = s1[i].w;
#pragma unroll
        for (int j = 0; j <= tq && j < W; ++j) { unpack8(r[i - j], x);
#pragma unroll
            for (int e = 0; e < 8; ++e) a[e] += x[e]; }
        unpack8(r[i], x);
        const float ic = 1.f / (float)W;
        v4u o; o.x = pk2(a[0] * ic - x[0], a[1] * ic - x[1]); o.y = pk2(a[2] * ic - x[2], a[3] * ic - x[3]); o.z = pk2(a[4] * ic - x[4], a[5] * ic - x[5]); o.w = pk2(a[6] * ic - x[6], a[7] * ic - x[7]);
        *(LAS v4u*)(PA + (t0 + i) * PP + c8 * 16) = o;
    }
}
template <int EXP = 0>
__device__ __forceinline__ void pool_item(Frame& F, int it) {
    int lane = F.lane, tid = F.tid; const int m0 = it * 64, wv = F.wave;
    asm volatile("" : "+v"(lane), "+v"(tid));
    LAS unsigned char* PA = F.lds + RING_OFF;
    const bool smp = m0 >= MP;
    const int i = lane & 15, q = lane >> 4, g2 = wv >> 1, half = wv & 1;
    bf16x8 wf[4][4]; f32x4 ps[4];
    v4u gbq[8];
#pragma unroll
    for (int k = 0; k < 8; ++k) { const int id = tid + 512 * k, t = id >> 6, c8 = id & 63; gbq[k] = *(const GAS v4u*)(F.GB + (size_t)(m0 + t) * 512 + c8 * 8); }
#pragma unroll
    for (int nt = 0; nt < 4; ++nt) ps[nt] = *(const f32x4*)(F.pool_scale + g2 * 128 + 64 * half + 16 * nt + 4 * q);
    __builtin_amdgcn_sched_barrier(0);
    if (EXP != 2) {
        const int g = wv >> 1;
        if (!smp) { if (g == 0) pool_rows_prompt<2>(F, m0, PA); else if (g == 1) pool_rows_prompt<4>(F, m0, PA); else if (g == 2) pool_rows_prompt<8>(F, m0, PA); else pool_rows_prompt<16>(F, m0, PA); }
        else { if (g == 0) pool_rows_sample<2>(F, m0, PA); else if (g == 1) pool_rows_sample<4>(F, m0, PA); else if (g == 2) pool_rows_sample<8>(F, m0, PA); else pool_rows_sample<16>(F, m0, PA); }
    }
    __builtin_amdgcn_sched_barrier(0);
#pragma unroll
    for (int nt = 0; nt < 4; ++nt)
#pragma unroll
        for (int ks = 0; ks < 4; ++ks) wf[nt][ks] = *(const GAS bf16x8*)(F.WpT + ((size_t)g2 * 128 + 64 * half + 16 * nt + i) * 128 + 32 * ks + 8 * q);
    __builtin_amdgcn_sched_barrier(0);
    WG_BAR();
    if (EXP != 1) {
        f32x4 acc[4][4];
#pragma unroll
        for (int mt = 0; mt < 4; ++mt)
#pragma unroll
            for (int nt = 0; nt < 4; ++nt) acc[mt][nt] = (f32x4){0.f, 0.f, 0.f, 0.f};
#pragma unroll
        for (int mt = 0; mt < 4; ++mt)
#pragma unroll
            for (int ks = 0; ks < 4; ++ks) { const bf16x8 bf = *(const LAS bf16x8*)(PA + (16 * mt + i) * PP + (g2 * 128 + 32 * ks + 8 * q) * 2);
#pragma unroll
                for (int nt = 0; nt < 4; ++nt) acc[mt][nt] = __builtin_amdgcn_mfma_f32_16x16x32_bf16(wf[nt][ks], bf, acc[mt][nt], 0, 0, 0); }
        WG_BAR();
#pragma unroll
        for (int mt = 0; mt < 4; ++mt)
#pragma unroll
            for (int nt = 0; nt < 4; ++nt) { const int col = g2 * 128 + 64 * half + 16 * nt + 4 * q;
                v2u o; o.x = pk2(acc[mt][nt][0] * ps[nt].x, acc[mt][nt][1] * ps[nt].y); o.y = pk2(acc[mt][nt][2] * ps[nt].z, acc[mt][nt][3] * ps[nt].w);
                *(LAS v2u*)(PA + (16 * mt + i) * PP + col * 2) = o; }
        WG_BAR();
#pragma unroll
        for (int k = 0; k < 8; ++k) { const int id = tid + 512 * k, t = id >> 6, c8 = id & 63;
            const v4u mx = *(const LAS v4u*)(PA + t * PP + c8 * 16), g = gbq[k];
            v4u o; o.x = pk2(bflo(mx.x) * bflo(g.x), bfhi(mx.x) * bfhi(g.x)); o.y = pk2(bflo(mx.y) * bflo(g.y), bfhi(mx.y) * bfhi(g.y));
            o.z = pk2(bflo(mx.z) * bflo(g.z), bfhi(mx.z) * bfhi(g.z)); o.w = pk2(bflo(mx.w) * bflo(g.w), bfhi(mx.w) * bfhi(g.w));
            *(GAS v4u*)(F.OY + (size_t)(m0 + t) * 1024 + 512 + c8 * 8) = o; }
    }
    WG_BAR();
}

constexpr int PQ = 272, PT = 80, POB = 528;
constexpr int IMG_QE = 0, IMG_KE = IMG_QE + 32 * PQ, IMG_K2T = IMG_KE + 32 * PQ, IMG_VT = IMG_K2T + 128 * PT, IMG_DEC = IMG_VT + 128 * PT, IMG_ER = IMG_DEC + 512, IMG_BYTES = IMG_ER + 512;
constexpr int L_OB0 = 2 * IMG_BYTES, L_HEND = L_OB0 + 2 * 32 * POB;
static_assert(L_HEND <= RING_BYTES && IMG_K2T % 16 == 0 && IMG_VT % 16 == 0 && IMG_DEC % 16 == 0 && IMG_ER % 16 == 0 && IMG_BYTES % 16 == 0 && L_OB0 % 16 == 0, "hgrn lds map");
struct HgrnItem {
    int m0, nchunks, h;
    const float* s_start;
    float* s_out;
    float* u_out; float* d_out;
    gu32* pub;
};
#ifndef HG_PFD
#define HG_PFD 1
#endif
struct HgRaw { float lf[8][2]; unsigned q[8], v[8]; };
template <bool FULL>
__device__ __forceinline__ void hg_load(const Frame& F, const HgrnItem& it, HgRaw& r, int ck, int tg, int d0) {
    const size_t rb = ((size_t)it.h * M + it.m0 + 32 * ck + 8 * tg) * 128 + d0;
#pragma unroll
    for (int j = 0; j < 8; ++j) { const f16v2 l2 = *(const f16v2*)(F.LOGF + rb + (size_t)j * 128); r.lf[j][0] = (float)l2.x; r.lf[j][1] = (float)l2.y;
        r.q[j] = FULL ? *(const unsigned*)(F.QF + rb + (size_t)j * 128) : 0u; r.v[j] = *(const unsigned*)(F.V + rb + (size_t)j * 128); }
}
template <bool FULL>
__device__ __forceinline__ void hg_a_stage(const Frame& F, const HgrnItem& it, LAS unsigned char* L, const HgRaw& cur, HgRaw& nxt, int s, int n, int lane, int tg, int d0, int nt_, int nc16, float& cum0, float& cum1, const f32x4 (&gn)[4]) {
    v4u ga0 = (v4u){0u, 0u, 0u, 0u}, ga1 = ga0;
    const size_t noff = ((size_t)it.h * M + it.m0 + 32 * (s - 2) + nt_) * 128 + 16 * nc16;
    if (FULL && s >= 2) { ga0 = *(const GAS v4u*)(F.GA + noff); ga1 = *(const GAS v4u*)(F.GA + noff + 8); }
    __builtin_amdgcn_sched_barrier(0);
    if (s + HG_PFD < n) hg_load<FULL>(F, it, nxt, s + HG_PFD, tg, d0);
    __builtin_amdgcn_sched_barrier(0);
    if (s < n) {
        LAS unsigned char* IM = L + (s & 1) * IMG_BYTES;
        float c0[8], c1[8];
        c0[0] = cur.lf[0][0]; c1[0] = cur.lf[0][1];
#pragma unroll
        for (int j = 1; j < 8; ++j) { c0[j] = c0[j - 1] + cur.lf[j][0]; c1[j] = c1[j - 1] + cur.lf[j][1]; }
        float t0[4], t1[4];
#pragma unroll
        for (int g = 0; g < 4; ++g) { t0[g] = __shfl(c0[7], (lane & 15) + 16 * g); t1[g] = __shfl(c1[7], (lane & 15) + 16 * g); }
        const float f0 = __shfl(cur.lf[0][0], (lane & 15) + 32), f1 = __shfl(cur.lf[0][1], (lane & 15) + 32);
        const float off0 = tg == 0 ? 0.f : (tg == 1 ? t0[0] : (tg == 2 ? t0[0] + t0[1] : t0[0] + t0[1] + t0[2]));
        const float off1 = tg == 0 ? 0.f : (tg == 1 ? t1[0] : (tg == 2 ? t1[0] + t1[1] : t1[0] + t1[1] + t1[2]));
        const float b31_0 = (t0[0] + t0[1]) + (t0[2] + t0[3]), b31_1 = (t1[0] + t1[1]) + (t1[2] + t1[3]);
        const float r0 = t0[0] + t0[1] + f0, r1 = t1[0] + t1[1] + f1;
        const float er0 = fex2(r0), er1 = fex2(r1), ew0 = fex2(b31_0 - r0), ew1 = fex2(b31_1 - r1);
        float k2a[8], k2b[8];
#pragma unroll
        for (int j = 0; j < 8; ++j) {
            const float ba = off0 + c0[j], bb = off1 + c1[j];
            const float ka = 1.f - fex2(cur.lf[j][0]), kb = 1.f - fex2(cur.lf[j][1]);
            if (FULL) {
                const float e1a = fex2(ba - r0), e1b = fex2(bb - r1);
                const float kea = ka * __builtin_amdgcn_rcpf(e1a), keb = kb * __builtin_amdgcn_rcpf(e1b);
                const float qea = bflo(cur.q[j]) * e1a, qeb = bfhi(cur.q[j]) * e1b;
                const int srow = 8 * tg + j;
                *(LAS unsigned*)(IM + IMG_QE + srow * PQ + d0 * 2) = pk2(qea, qeb);
                *(LAS unsigned*)(IM + IMG_KE + srow * PQ + d0 * 2) = pk2(kea, keb);
                k2a[j] = kea * ew0; k2b[j] = keb * ew1;
            } else { k2a[j] = ka * fex2(b31_0 - ba); k2b[j] = kb * fex2(b31_1 - bb); }
        }
        { v4u o; o.x = pk2(k2a[0], k2a[1]); o.y = pk2(k2a[2], k2a[3]); o.z = pk2(k2a[4], k2a[5]); o.w = pk2(k2a[6], k2a[7]); *(LAS v4u*)(IM + IMG_K2T + d0 * PT + tg * 16) = o; }
        { v4u o; o.x = pk2(k2b[0], k2b[1]); o.y = pk2(k2b[2], k2b[3]); o.z = pk2(k2b[4], k2b[5]); o.w = pk2(k2b[6], k2b[7]); *(LAS v4u*)(IM + IMG_K2T + (d0 + 1) * PT + tg * 16) = o; }
        const unsigned* vv = cur.v;
        { v4u o; o.x = (vv[0] & 0xffffu) | (vv[1] << 16); o.y = (vv[2] & 0xffffu) | (vv[3] << 16); o.z = (vv[4] & 0xffffu) | (vv[5] << 16); o.w = (vv[6] & 0xffffu) | (vv[7] << 16); *(LAS v4u*)(IM + IMG_VT + d0 * PT + tg * 16) = o; }
        { v4u o; o.x = (vv[0] >> 16) | (vv[1] & 0xffff0000u); o.y = (vv[2] >> 16) | (vv[3] & 0xffff0000u); o.z = (vv[4] >> 16) | (vv[5] & 0xffff0000u); o.w = (vv[6] >> 16) | (vv[7] & 0xffff0000u); *(LAS v4u*)(IM + IMG_VT + (d0 + 1) * PT + tg * 16) = o; }
        if (tg == 0) { *(LAS f32v2*)(IM + IMG_DEC + d0 * 4) = (f32v2){fex2(b31_0), fex2(b31_1)}; if (FULL) *(LAS f32v2*)(IM + IMG_ER + d0 * 4) = (f32v2){er0, er1}; cum0 += b31_0; cum1 += b31_1; }
    }
    if (FULL && s >= 2) {
        const LAS unsigned char* OBs = L + L_OB0 + (s & 1) * (32 * POB) + nt_ * POB + nc16 * 64;
        const f32x4 x0 = *(const LAS f32x4*)(OBs), x1 = *(const LAS f32x4*)(OBs + 16), x2 = *(const LAS f32x4*)(OBs + 32), x3 = *(const LAS f32x4*)(OBs + 48);
        float ss = ((x0.x * x0.x + x0.y * x0.y) + (x0.z * x0.z + x0.w * x0.w)) + ((x1.x * x1.x + x1.y * x1.y) + (x1.z * x1.z + x1.w * x1.w))
                 + ((x2.x * x2.x + x2.y * x2.y) + (x2.z * x2.z + x2.w * x2.w)) + ((x3.x * x3.x + x3.y * x3.y) + (x3.z * x3.z + x3.w * x3.w));
        ss += __shfl_xor(ss, 1); ss += __shfl_xor(ss, 2); ss += __shfl_xor(ss, 4);
        const float rstd = __builtin_amdgcn_rsqf(ss * (1.f / 128.f) + EPS);
        const f32x4 g0 = gn[0] * rstd, g1 = gn[1] * rstd, g2 = gn[2] * rstd, g3 = gn[3] * rstd;
        v4u o0, o1;
        o0.x = pk2(x0.x * g0.x * bflo(ga0.x), x0.y * g0.y * bfhi(ga0.x)); o0.y = pk2(x0.z * g0.z * bflo(ga0.y), x0.w * g0.w * bfhi(ga0.y));
        o0.z = pk2(x1.x * g1.x * bflo(ga0.z), x1.y * g1.y * bfhi(ga0.z)); o0.w = pk2(x1.z * g1.z * bflo(ga0.w), x1.w * g1.w * bfhi(ga0.w));
        o1.x = pk2(x2.x * g2.x * bflo(ga1.x), x2.y * g2.y * bfhi(ga1.x)); o1.y = pk2(x2.z * g2.z * bflo(ga1.y), x2.w * g2.w * bfhi(ga1.y));
        o1.z = pk2(x3.x * g3.x * bflo(ga1.z), x3.y * g3.y * bfhi(ga1.z)); o1.w = pk2(x3.z * g3.z * bflo(ga1.w), x3.w * g3.w * bfhi(ga1.w));
        const size_t ooff = (size_t)(it.m0 + 32 * (s - 2) + nt_) * 1024 + it.h * 128 + 16 * nc16;
        *(GAS v4u*)(F.OY + ooff) = o0; *(GAS v4u*)(F.OY + ooff + 8) = o1;
    }
}
template <bool FULL>
__device__ __forceinline__ void hgrn_pipe(Frame& F, const HgrnItem& it) {
    int tid = F.tid, lane = F.lane; const int wv = F.wave;
    LAS unsigned char* L = F.lds + RING_OFF;
    constexpr int n = SCH;
    constexpr int nstage = FULL ? n + 2 : n + 1;
    WG_BAR();
    if (wv < 4) {
        asm volatile("" : "+v"(tid), "+v"(lane));
        const int dp = 16 * wv + (lane & 15), d0 = 2 * dp, tg = lane >> 4;
        const int nt_ = tid >> 3, nc16 = tid & 7;
        float cum0 = 0.f, cum1 = 0.f;
        HgRaw r[HG_PFD + 1];
        f32x4 gn[4];
#pragma unroll
        for (int j = 0; j < 4; ++j) gn[j] = FULL ? *(const f32x4*)(F.hgrn_norm_g + 16 * nc16 + 4 * j) : (f32x4){0.f, 0.f, 0.f, 0.f};
#pragma unroll
        for (int c = 0; c < HG_PFD && c < n; ++c) hg_load<FULL>(F, it, r[c], c, tg, d0);
#pragma unroll
        for (int s = 0; s < nstage; ++s) {
            hg_a_stage<FULL>(F, it, L, r[s % (HG_PFD + 1)], r[(s + HG_PFD) % (HG_PFD + 1)], s, n, lane, tg, d0, nt_, nc16, cum0, cum1, gn);
            WG_BAR();
        }
        if (it.d_out) { if (tg == 0) { v2u w; w.x = __builtin_bit_cast(unsigned, fex2(cum0)); w.y = __builtin_bit_cast(unsigned, fex2(cum1)); store8_sc1(it.d_out + d0, w); }
            asm volatile("s_waitcnt vmcnt(0)" ::: "memory"); if (lane == 0) __hip_atomic_fetch_add(it.pub, 1u, RLX_AGENT); }
    } else {
        asm volatile("" : "+v"(lane));
        const int i = lane & 15, q = lane >> 4, wb = wv & 3;
        f32x4 Sacc[2][8];
#pragma unroll
        for (int sl = 0; sl < 2; ++sl)
#pragma unroll
            for (int dt = 0; dt < 8; ++dt) Sacc[sl][dt] = it.s_start ? *(const f32x4*)(it.s_start + ((size_t)(sl * 8 + dt) * 256 + wb * 64 + lane) * 4) : (f32x4){0.f, 0.f, 0.f, 0.f};
#pragma unroll 1
        for (int s = 0; s < nstage; ++s) {
            if (s >= 1 && s <= n) {
                const LAS unsigned char* IM = L + ((s - 1) & 1) * IMG_BYTES;
                f32x4 p00 = (f32x4){0.f, 0.f, 0.f, 0.f}, p01 = p00, p11 = p00;
                if (FULL) {
#pragma unroll
                    for (int ks = 0; ks < 4; ++ks) {
                        const bf16x8 a0 = *(const LAS bf16x8*)(IM + IMG_KE + i * PQ + (32 * ks + 8 * q) * 2), a1 = *(const LAS bf16x8*)(IM + IMG_KE + (16 + i) * PQ + (32 * ks + 8 * q) * 2);
                        const bf16x8 b0 = *(const LAS bf16x8*)(IM + IMG_QE + i * PQ + (32 * ks + 8 * q) * 2), b1 = *(const LAS bf16x8*)(IM + IMG_QE + (16 + i) * PQ + (32 * ks + 8 * q) * 2);
                        p00 = __builtin_amdgcn_mfma_f32_16x16x32_bf16(a0, b0, p00, 0, 0, 0);
                        p01 = __builtin_amdgcn_mfma_f32_16x16x32_bf16(a0, b1, p01, 0, 0, 0);
                        p11 = __builtin_amdgcn_mfma_f32_16x16x32_bf16(a1, b1, p11, 0, 0, 0);
                    }
#pragma unroll
                    for (int r = 0; r < 4; ++r) { const bool keep = (4 * q + r) <= i; p00[r] = keep ? p00[r] : 0.f; p11[r] = keep ? p11[r] : 0.f; }
                }
                v4u pa0, pa1; pa0.x = pk2(p00[0], p00[1]); pa0.y = pk2(p00[2], p00[3]); pa0.z = 0u; pa0.w = 0u;
                pa1.x = pk2(p01[0], p01[1]); pa1.y = pk2(p01[2], p01[3]); pa1.z = pk2(p11[0], p11[1]); pa1.w = pk2(p11[2], p11[3]);
                const int dv0 = 32 * wb + i, dv1 = dv0 + 16;
                const bf16x8 vnat0 = *(const LAS bf16x8*)(IM + IMG_VT + dv0 * PT + 16 * q), vnat1 = *(const LAS bf16x8*)(IM + IMG_VT + dv1 * PT + 16 * q);
                if (FULL) {
                    const s16x4 v0l = *(const LAS s16x4*)(IM + IMG_VT + dv0 * PT + 8 * q), v0h = *(const LAS s16x4*)(IM + IMG_VT + dv0 * PT + 32 + 8 * q);
                    const s16x4 v1l = *(const LAS s16x4*)(IM + IMG_VT + dv1 * PT + 8 * q), v1h = *(const LAS s16x4*)(IM + IMG_VT + dv1 * PT + 32 + 8 * q);
                    const bf16x8 vp0 = __builtin_shufflevector(v0l, v0h, 0, 1, 2, 3, 4, 5, 6, 7), vp1 = __builtin_shufflevector(v1l, v1h, 0, 1, 2, 3, 4, 5, 6, 7);
                    const f32x4 z4 = (f32x4){0.f, 0.f, 0.f, 0.f};
                    f32x4 O00 = __builtin_amdgcn_mfma_f32_16x16x32_bf16(__builtin_bit_cast(bf16x8, pa0), vp0, z4, 0, 0, 0);
                    f32x4 O01 = __builtin_amdgcn_mfma_f32_16x16x32_bf16(__builtin_bit_cast(bf16x8, pa1), vp0, z4, 0, 0, 0);
                    f32x4 O10 = __builtin_amdgcn_mfma_f32_16x16x32_bf16(__builtin_bit_cast(bf16x8, pa0), vp1, z4, 0, 0, 0);
                    f32x4 O11 = __builtin_amdgcn_mfma_f32_16x16x32_bf16(__builtin_bit_cast(bf16x8, pa1), vp1, z4, 0, 0, 0);
#pragma unroll
                    for (int ks = 0; ks < 4; ++ks) {
                        const f32x4 e0 = *(const LAS f32x4*)(IM + IMG_ER + (32 * ks + 4 * q) * 4), e1 = *(const LAS f32x4*)(IM + IMG_ER + (32 * ks + 16 + 4 * q) * 4);
                        const s16x4 a0l = *(const LAS s16x4*)(IM + IMG_QE + i * PQ + (32 * ks + 4 * q) * 2), a0h = *(const LAS s16x4*)(IM + IMG_QE + i * PQ + (32 * ks + 16 + 4 * q) * 2);
                        const s16x4 a1l = *(const LAS s16x4*)(IM + IMG_QE + (16 + i) * PQ + (32 * ks + 4 * q) * 2), a1h = *(const LAS s16x4*)(IM + IMG_QE + (16 + i) * PQ + (32 * ks + 16 + 4 * q) * 2);
                        const bf16x8 qa0 = __builtin_shufflevector(a0l, a0h, 0, 1, 2, 3, 4, 5, 6, 7), qa1 = __builtin_shufflevector(a1l, a1h, 0, 1, 2, 3, 4, 5, 6, 7);
                        const f32x4 s00 = Sacc[0][2 * ks] * e0, s01 = Sacc[0][2 * ks + 1] * e1, s10 = Sacc[1][2 * ks] * e0, s11 = Sacc[1][2 * ks + 1] * e1;
                        v4u sb0, sb1; sb0.x = pk2(s00[0], s00[1]); sb0.y = pk2(s00[2], s00[3]); sb0.z = pk2(s01[0], s01[1]); sb0.w = pk2(s01[2], s01[3]);
                        sb1.x = pk2(s10[0], s10[1]); sb1.y = pk2(s10[2], s10[3]); sb1.z = pk2(s11[0], s11[1]); sb1.w = pk2(s11[2], s11[3]);
                        O00 = __builtin_amdgcn_mfma_f32_16x16x32_bf16(qa0, __builtin_bit_cast(bf16x8, sb0), O00, 0, 0, 0);
                        O01 = __builtin_amdgcn_mfma_f32_16x16x32_bf16(qa1, __builtin_bit_cast(bf16x8, sb0), O01, 0, 0, 0);
                        O10 = __builtin_amdgcn_mfma_f32_16x16x32_bf16(qa0, __builtin_bit_cast(bf16x8, sb1), O10, 0, 0, 0);
                        O11 = __builtin_amdgcn_mfma_f32_16x16x32_bf16(qa1, __builtin_bit_cast(bf16x8, sb1), O11, 0, 0, 0);
                    }
                    LAS unsigned char* OBw = L + L_OB0 + ((s - 1) & 1) * (32 * POB);
#pragma unroll
                    for (int r = 0; r < 4; ++r) { ((LAS float*)(OBw + (4 * q + r) * POB))[dv0] = O00[r]; ((LAS float*)(OBw + (16 + 4 * q + r) * POB))[dv0] = O01[r];
                                                  ((LAS float*)(OBw + (4 * q + r) * POB))[dv1] = O10[r]; ((LAS float*)(OBw + (16 + 4 * q + r) * POB))[dv1] = O11[r]; }
                }
#pragma unroll
                for (int dt = 0; dt < 8; ++dt) {
                    const f32x4 dd = *(const LAS f32x4*)(IM + IMG_DEC + (16 * dt + 4 * q) * 4);
                    const bf16x8 ka = *(const LAS bf16x8*)(IM + IMG_K2T + (16 * dt + i) * PT + 16 * q);
                    Sacc[0][dt] = __builtin_amdgcn_mfma_f32_16x16x32_bf16(ka, vnat0, dd * Sacc[0][dt], 0, 0, 0);
                    Sacc[1][dt] = __builtin_amdgcn_mfma_f32_16x16x32_bf16(ka, vnat1, dd * Sacc[1][dt], 0, 0, 0);
                }
            }
            WG_BAR();
        }
        if (it.u_out) {
#pragma unroll
            for (int sl = 0; sl < 2; ++sl)
#pragma unroll
                for (int dt = 0; dt < 8; ++dt) store16_sc1(it.u_out + ((size_t)(sl * 8 + dt) * 256 + wb * 64 + lane) * 4, __builtin_bit_cast(pg8::u32x4, Sacc[sl][dt]));
            asm volatile("s_waitcnt vmcnt(0)" ::: "memory"); if (lane == 0) __hip_atomic_fetch_add(it.pub, 1u, RLX_AGENT);
        }
        if (it.s_out) {
#pragma unroll
            for (int sl = 0; sl < 2; ++sl)
#pragma unroll
                for (int dt = 0; dt < 8; ++dt)
#pragma unroll
                    for (int r = 0; r < 4; ++r) it.s_out[(size_t)(16 * dt + 4 * q + r) * DV + 32 * wb + 16 * sl + i] = Sacc[sl][dt][r];
        }
    }
}

constexpr int DL_Q2 = 0, DL_K2 = 2048, DL_DEC = 4096, DL_V = 4608, DL_RED = 6656, DL_RED2 = 6784, DL_OP = 8192, DL_END = DL_OP + 16 * 4 * 128 * 4;
static_assert(2 * DL_END <= RING_BYTES, "decode lds map");
template <int NE>
__device__ __forceinline__ void decode_items(Frame& F, int idx0, int idx1) {
    int tid = F.tid, lane = F.lane; const int wv = F.wave;
    asm volatile("" : "+v"(tid), "+v"(lane));
    WG_BAR();
    const int v4i = tid & 31, slab = tid >> 5;
    f32x4 s4[NE][8]; float gav[NE], vraw[NE]; float lfv[NE][4], qfv[NE][4];
#pragma unroll
    for (int e = 0; e < NE; ++e) { const int idx = e ? idx1 : idx0; const float* S0 = F.state_hgrn + (size_t)idx * DK * DV;
#pragma unroll
        for (int dd = 0; dd < 8; ++dd) s4[e][dd] = *(const f32x4*)(S0 + (size_t)(8 * slab + dd) * DV + 4 * v4i); }
#pragma unroll
    for (int e = 0; e < NE; ++e) { const int idx = e ? idx1 : idx0, h = idx & 3, m0 = MP + (idx >> 2) * DT; const int t = tid >> 7, v = tid & 127;
        const size_t off = ((size_t)h * M + m0 + t) * 128 + v;
        vraw[e] = bflo((unsigned)F.V[off]); gav[e] = bflo((unsigned)F.GA[off]);
        if (tid < 128) {
#pragma unroll
            for (int tt = 0; tt < 4; ++tt) { lfv[e][tt] = (float)F.LOGF[((size_t)h * M + m0 + tt) * 128 + tid]; qfv[e][tt] = bflo((unsigned)F.QF[((size_t)h * M + m0 + tt) * 128 + tid]); }
        }
    }
    const float gnv = F.hgrn_norm_g[tid & 127];
#pragma unroll
    for (int e = 0; e < NE; ++e) { LAS unsigned char* L = F.lds + RING_OFF + e * DL_END;
        ((LAS float*)(L + DL_V))[tid] = vraw[e];
        if (tid < 128) {
            const int d = tid; float bb[4], kk[4];
            bb[0] = lfv[e][0]; bb[1] = bb[0] + lfv[e][1]; bb[2] = bb[1] + lfv[e][2]; bb[3] = bb[2] + lfv[e][3];
#pragma unroll
            for (int t = 0; t < 4; ++t) kk[t] = 1.f - fex2(lfv[e][t]);
            f32x4 q2, k2;
#pragma unroll
            for (int t = 0; t < 4; ++t) { q2[t] = qfv[e][t] * fex2(bb[t]); k2[t] = kk[t] * fex2(bb[3] - bb[t]); }
            *(LAS f32x4*)(L + DL_Q2 + d * 16) = q2; *(LAS f32x4*)(L + DL_K2 + d * 16) = k2; ((LAS float*)(L + DL_DEC))[d] = fex2(bb[3]);
            int pi = 0;
#pragma unroll
            for (int t = 0; t < 4; ++t)
#pragma unroll
                for (int s = 0; s <= t; ++s) { const float pv = wave_sum(qfv[e][t] * kk[s] * fex2(bb[t] - bb[s])); if (lane == 0) ((LAS float*)(L + DL_RED))[wv * 16 + pi] = pv; ++pi; }
        }
    }
    __syncthreads();
#pragma unroll
    for (int e = 0; e < NE; ++e) { LAS unsigned char* L = F.lds + RING_OFF + e * DL_END; const int idx = e ? idx1 : idx0; float* S1 = F.out + O_SHS + (size_t)idx * DK * DV;
        f32x4 V4[4], o[4];
#pragma unroll
        for (int t = 0; t < 4; ++t) { V4[t] = *(const LAS f32x4*)(L + DL_V + (t * 128 + 4 * v4i) * 4); o[t] = (f32x4){0.f, 0.f, 0.f, 0.f}; }
#pragma unroll
        for (int dd = 0; dd < 8; ++dd) {
            const int d = 8 * slab + dd;
            const f32x4 q2 = *(const LAS f32x4*)(L + DL_Q2 + d * 16), k2 = *(const LAS f32x4*)(L + DL_K2 + d * 16); const float dec = ((const LAS float*)(L + DL_DEC))[d];
#pragma unroll
            for (int t = 0; t < 4; ++t) o[t] += q2[t] * s4[e][dd];
            f32x4 sn = dec * s4[e][dd];
#pragma unroll
            for (int t = 0; t < 4; ++t) sn += k2[t] * V4[t];
            *(f32x4*)(S1 + (size_t)d * DV + 4 * v4i) = sn;
        }
#pragma unroll
        for (int t = 0; t < 4; ++t) *(LAS f32x4*)(L + DL_OP + ((slab * 4 + t) * 128 + 4 * v4i) * 4) = o[t];
    }
    __syncthreads();
    const int t = tid >> 7, v = tid & 127;
    float ov[NE];
#pragma unroll
    for (int e = 0; e < NE; ++e) { LAS unsigned char* L = F.lds + RING_OFF + e * DL_END;
        float o = 0.f;
#pragma unroll
        for (int sb = 0; sb < 16; ++sb) o += ((const LAS float*)(L + DL_OP))[(sb * 4 + t) * 128 + v];
        const LAS float* R = (const LAS float*)(L + DL_RED);
#pragma unroll
        for (int s = 0; s < 4; ++s) if (s <= t) { const int pi = (t * (t + 1)) / 2 + s; o += (R[pi] + R[16 + pi]) * ((const LAS float*)(L + DL_V))[s * 128 + v]; }
        ov[e] = o;
        const float ssw = wave_sum(o * o);
        if (lane == 0) ((LAS float*)(L + DL_RED2))[wv] = ssw;
    }
    __syncthreads();
#pragma unroll
    for (int e = 0; e < NE; ++e) { LAS unsigned char* L = F.lds + RING_OFF + e * DL_END; const int idx = e ? idx1 : idx0, h = idx & 3, m0 = MP + (idx >> 2) * DT;
        const float ss = ((const LAS float*)(L + DL_RED2))[2 * t] + ((const LAS float*)(L + DL_RED2))[2 * t + 1];
        const float rstd = __builtin_amdgcn_rsqf(ss * (1.f / 128.f) + EPS);
        F.OY[(size_t)(m0 + t) * 1024 + h * 128 + v] = (bf16)f2bf(ov[e] * rstd * gnv * gav[e]);
    }
}

constexpr int XL_P = LDSCTL_OFF + 1024, XL_S = XL_P + 4096, XL_FLAG = XL_S + 1024;
static_assert(XL_FLAG + 64 <= LDS_BYTES, "exchange scratch");
#define TAIL_SPIN_CAP (1u << 22)
struct OrderTail : pg8::TileOrder {
    const char *OYp, *Wab, *MGp, *Wout; gu32* cnt1;
    int t0, stride, count, kind2;
    int xt, xh;
    __device__ __forceinline__ bool next(int i, pg8::Unit& u) const {
        if (kind2) { if (i) return false; u.kind = 2; u.pm = t0 >> 2; u.pn = t0 & 3; u.half = xh >= 0; u.r0 = u.pm * 256 + (xh > 0 ? 128 : 0); return true; }
        if (i < count) { const int t = t0 + stride * i; u.kind = 1; u.pm = t >> 2; u.pn = t & 3; u.half = 0; u.r0 = u.pm * 256; return true; }
        if (i == count && xt >= 0) { u.kind = 1; u.pm = xt >> 2; u.pn = xt & 3; u.half = 1; u.r0 = u.pm * 256 + xh * 128; return true; }
        return false; }
    __device__ __forceinline__ const char* opA(const pg8::Unit& u) const { return (u.kind == 2 ? MGp : OYp) + (size_t)u.r0 * 2048; }
    __device__ __forceinline__ const char* opB(const pg8::Unit& u) const { return (u.kind == 2 ? Wout : Wab) + (size_t)u.pn * (256 * 2048); }
    __device__ __forceinline__ int nt(const pg8::Unit&) const { return 16; }
    __device__ __forceinline__ int mid_at(const pg8::Unit& u) const { return u.kind == 1 ? 8 : -1; }
    __device__ __forceinline__ void done(const pg8::Unit& u, int lane) const {
        if (u.kind == 1) { asm volatile("s_waitcnt vmcnt(0)" ::: "memory"); if (lane == 0) __hip_atomic_fetch_add(cnt1 + 64 * u.pm, u.half ? 1u : 2u, RLX_AGENT); }
    }
};
struct EpiTail {
    static constexpr bool PERM = true, AFTER_DRAIN = false, HAS_MID = true;
    const bf16 *RA, *GBm; bf16* MG;
    const float *xp, *xs, *fg; float* out; float* xbuf; gu32* cnt2; LAS unsigned char* lds;
    __device__ __forceinline__ void mid(f32x4 (&acc)[2][2][4][2], const pg8::Unit& u, int wr, int wc, int fr, int fq) const {
        asm volatile("" : "+v"(fr), "+v"(fq));
        const int row0 = u.r0 + wr * 64 + fr, col0 = u.pn * 256 + wc * 32 + 8 * fq, nai = u.half ? 1 : 2;
        v4u rq[2][4][2];
#pragma unroll
        for (int ai = 0; ai < 2; ++ai) if (ai < nai)
#pragma unroll
            for (int m = 0; m < 4; ++m)
#pragma unroll
                for (int bj = 0; bj < 2; ++bj) rq[ai][m][bj] = *(const GAS v4u*)(RA + (size_t)(row0 + ai * 128 + m * 16) * 1024 + col0 + bj * 128);
        __builtin_amdgcn_sched_barrier(0);
#pragma unroll
        for (int ai = 0; ai < 2; ++ai) if (ai < nai)
#pragma unroll
            for (int m = 0; m < 4; ++m)
#pragma unroll
                for (int bj = 0; bj < 2; ++bj) { const v4u g = rq[ai][m][bj];
                    acc[ai][bj][m][0][0] *= bflo(g.x); acc[ai][bj][m][0][1] *= bfhi(g.x); acc[ai][bj][m][0][2] *= bflo(g.y); acc[ai][bj][m][0][3] *= bfhi(g.y);
                    acc[ai][bj][m][1][0] *= bflo(g.z); acc[ai][bj][m][1][1] *= bfhi(g.z); acc[ai][bj][m][1][2] *= bflo(g.w); acc[ai][bj][m][1][3] *= bfhi(g.w); }
        __builtin_amdgcn_sched_barrier(0);
    }
    __device__ __forceinline__ void operator()(const f32x4 (&acc)[2][2][4][2], const pg8::Unit& u, int wr, int wc, int fr, int fq, int wid, int lane) const {
        asm volatile("" : "+v"(fr), "+v"(fq));
        const int row0 = u.r0 + wr * 64 + fr, col0 = u.pn * 256 + wc * 32 + 8 * fq, nai = u.half ? 1 : 2;
        if (u.kind < 2) {
            v4u gq[2][4][2];
#pragma unroll
            for (int ai = 0; ai < 2; ++ai) if (ai < nai)
#pragma unroll
                for (int m = 0; m < 4; ++m)
#pragma unroll
                    for (int bj = 0; bj < 2; ++bj) gq[ai][m][bj] = *(const GAS v4u*)(GBm + (size_t)(row0 + ai * 128 + m * 16) * 1024 + col0 + bj * 128);
            __builtin_amdgcn_sched_barrier(0);
#pragma unroll
            for (int ai = 0; ai < 2; ++ai) if (ai < nai)
#pragma unroll
                for (int m = 0; m < 4; ++m)
#pragma unroll
                    for (int bj = 0; bj < 2; ++bj) { const size_t off = (size_t)(row0 + ai * 128 + m * 16) * 1024 + col0 + bj * 128;
                        const v4u g = gq[ai][m][bj]; const f32x4 v0 = acc[ai][bj][m][0], v1 = acc[ai][bj][m][1];
                        pg8::u32x4 w; w.x = pk2(v0[0] * bflo(g.x), v0[1] * bfhi(g.x)); w.y = pk2(v0[2] * bflo(g.y), v0[3] * bfhi(g.y)); w.z = pk2(v1[0] * bflo(g.z), v1[1] * bfhi(g.z)); w.w = pk2(v1[2] * bflo(g.w), v1[3] * bfhi(g.w));
                        store16_sc1(MG + off, w); }
            return;
        }
        f32x4 o[2][2][4][2];
        LAS float* P = (LAS float*)(lds + XL_P); LAS float* S = (LAS float*)(lds + XL_S);
#pragma unroll
        for (int ai = 0; ai < 2; ++ai) if (ai < nai) {
            f32x4 xq[4][2][2];
#pragma unroll
            for (int m = 0; m < 4; ++m) { const int row = row0 + ai * 128 + m * 16;
                const float* xr = (row < MP ? xp + (size_t)row * D : xs + (size_t)(row - MP) * D) + col0;
#pragma unroll
                for (int bj = 0; bj < 2; ++bj)
#pragma unroll
                    for (int n = 0; n < 2; ++n) xq[m][bj][n] = *(const f32x4*)(xr + bj * 128 + n * 4); }
            __builtin_amdgcn_sched_barrier(0);
#pragma unroll
            for (int m = 0; m < 4; ++m) { float ss = 0.f;
#pragma unroll
                for (int bj = 0; bj < 2; ++bj)
#pragma unroll
                    for (int n = 0; n < 2; ++n) { const f32x4 v = xq[m][bj][n] + acc[ai][bj][m][n]; o[ai][bj][m][n] = v; ss += (v.x * v.x + v.y * v.y) + (v.z * v.z + v.w * v.w); }
                ss += __shfl_xor(ss, 16); ss += __shfl_xor(ss, 32);
                if (fq == 0) P[(ai * 128 + wr * 64 + m * 16 + fr) * 4 + wc] = ss; }
        }
        asm volatile("s_waitcnt lgkmcnt(0)" ::: "memory"); __builtin_amdgcn_s_barrier(); asm volatile("" ::: "memory");
        const int prow = wid * 32 + (lane & 31); const bool pub = lane < 32 && prow < nai * 128;
        gu32* const cw = cnt2 + (u.r0 >> 7) * 32;
        if (pub) { const f32x4 p = *(const LAS f32x4*)(P + prow * 4);
            __hip_atomic_store((gu32*)xbuf + ((size_t)(u.r0 + prow) * 4 + u.pn), __builtin_bit_cast(unsigned, (p.x + p.y) + (p.z + p.w)), RLX_AGENT); }
        asm volatile("s_waitcnt vmcnt(0)" ::: "memory");
        if (lane == 0) __hip_atomic_fetch_add(cw, 1u, RLX_AGENT);
        if (wid == 0) { unsigned sp = 0;
            while ((unsigned)__builtin_amdgcn_readfirstlane(__hip_atomic_load(cw, RLX_AGENT)) < 32u) { __builtin_amdgcn_s_sleep(2); if (++sp > TAIL_SPIN_CAP) break; }
            __builtin_amdgcn_fence(__ATOMIC_ACQUIRE, "agent"); }
        asm volatile("s_waitcnt vmcnt(0) lgkmcnt(0)" ::: "memory"); __builtin_amdgcn_s_barrier(); asm volatile("" ::: "memory");
        if (pub) { gu32* sl = (gu32*)xbuf + (size_t)(u.r0 + prow) * 4; float t = 0.f;
#pragma unroll
            for (int k = 0; k < 4; ++k) t += __builtin_bit_cast(float, __hip_atomic_load(sl + k, RLX_AGENT));
            S[prow] = __builtin_amdgcn_rsqf(t * (1.f / D) + EPS); }
        asm volatile("s_waitcnt lgkmcnt(0)" ::: "memory"); __builtin_amdgcn_s_barrier(); asm volatile("" ::: "memory");
        f32x4 gv[2][2];
#pragma unroll
        for (int bj = 0; bj < 2; ++bj)
#pragma unroll
            for (int n = 0; n < 2; ++n) gv[bj][n] = *(const f32x4*)(fg + col0 + bj * 128 + n * 4);
#pragma unroll
        for (int ai = 0; ai < 2; ++ai) if (ai < nai)
#pragma unroll
            for (int m = 0; m < 4; ++m) { const int r = ai * 128 + wr * 64 + m * 16 + fr; const float rstd = S[r]; float* orow = out + (size_t)(u.r0 + r) * D + col0;
#pragma unroll
                for (int bj = 0; bj < 2; ++bj)
#pragma unroll
                    for (int n = 0; n < 2; ++n) *(f32x4*)(orow + bj * 128 + n * 4) = o[ai][bj][m][n] * rstd * gv[bj][n]; }
    }
};
__device__ __forceinline__ void wait_panel(gu32* cnt1, int pm, int wave) {
    if (wave == 0) { unsigned sp = 0;
        while ((unsigned)__builtin_amdgcn_readfirstlane(__hip_atomic_load(cnt1 + 64 * pm, RLX_AGENT)) < 64u) { __builtin_amdgcn_s_sleep(2); if (++sp > TAIL_SPIN_CAP) break; }
        __builtin_amdgcn_fence(__ATOMIC_ACQUIRE, "agent"); asm volatile("s_waitcnt vmcnt(0)" ::: "memory"); }
    __syncthreads();
}

struct Args { const float* in[14]; float* out; unsigned char* ws; int ph_lo, ph_hi, li, pad; };
__global__ void __launch_bounds__(NWAVES * 64, 2) hgrn_pool_fwd(Args args) {
    extern __shared__ __attribute__((aligned(16))) unsigned char lds[];
    Frame F;
    F.lds = (LAS unsigned char*)lds;
    F.MISC = (volatile LAS unsigned*)(F.lds + MISC_OFF);
    F.tid = threadIdx.x; F.lane = F.tid & 63; F.wave = __builtin_amdgcn_readfirstlane(F.tid >> 6);
    F.G = gridDim.x;
    unsigned char* ws = args.ws;
    F.ctl = (gu32*)(ws + WS_CTL);
    F.x_prompt = args.in[0]; F.x_sample = args.in[1]; F.state_hgrn = args.in[2]; F.state_pool = args.in[3]; F.norm_g = args.in[4]; F.w_in = args.in[5]; F.lb_logits = args.in[6];
    F.hgrn_norm_g = args.in[7]; F.w_proj_a = args.in[8]; F.w_pool = args.in[9]; F.pool_scale = args.in[10]; F.w_proj_b = args.in[11]; F.w_out = args.in[12]; F.final_norm_g = args.in[13];
    F.out = args.out;
    F.WinT = (bf16*)(ws + WS_WIN); F.WabT = (bf16*)(ws + WS_WA); F.WoutT = (bf16*)(ws + WS_WOUT); F.WpT = (bf16*)(ws + WS_WP);
    F.XN = (bf16*)(ws + WS_XN); F.QF = (bf16*)(ws + WS_QF); F.V = (bf16*)(ws + WS_V); F.GA = (bf16*)(ws + WS_GA); F.U = (bf16*)(ws + WS_U); F.GB = (bf16*)(ws + WS_GB);
    F.MA = (bf16*)(ws + WS_MA); F.MB = (bf16*)(ws + WS_MB); F.OY = (bf16*)(ws + WS_OY); F.MG = (bf16*)(ws + WS_MG);
    F.LOGF = (f16*)(ws + WS_LOGF); F.PART = (float*)(ws + WS_PART); F.DTOT = (float*)(ws + WS_DTOT); F.UWS = (float*)(ws + WS_UWS); F.SUF = (float*)(ws + WS_SUF);
    for (int u = F.tid; u < (LDS_BYTES - LDSCTL_OFF) / 4; u += NWAVES * 64) ((LAS unsigned*)(F.lds + LDSCTL_OFF))[u] = 0u;
    __syncthreads();
    XcdBarrier bar; bar.bar = (unsigned*)(F.ctl + CW_BAR); bar.x = 0; bar.st = nullptr;
    if (N_LAUNCHES != PER_PHASE) bar = xcd_barrier_post((unsigned*)(F.ctl + CW_BAR), F.MISC + 8);
#define GRID_BAR(seam) do { if (N_LAUNCHES == PER_PHASE) { if (F.tid == 0) __hip_atomic_store(F.ctl + CW_TMO, 0xBADBA0u | (unsigned)(seam), RLX_AGENT); } else { xcd_barrier(bar); } } while (0)
    const int lo = args.ph_lo, hi = args.ph_hi;
#define IN(k) (lo <= (k) && (k) < hi)
#define BOTH(k) (IN(k) && IN((k) + 1))

    if (IN(0)) { p0_prologue(F); if (BOTH(0)) GRID_BAR(0); }

    if (IN(1)) {
        pg8::OrderSingle S; S.init(M, DIN, F.G, (int)blockIdx.x); S.A = (const char*)F.XN; S.Bt = (const char*)F.WinT; S.tstep = (size_t)256 * D * 2; S.ntiles = D / 64;
        S.split = (F.G == 256 && S.nwg % F.G != 0 && (S.nwg % F.G) * 2 <= F.G) ? 1 : 0;
        EpiZ E{F.QF, F.V, F.GA, F.U, F.GB, F.MA, F.MB, F.LOGF, F.lb_logits, F.out + O_SPP, F.out + O_SPS};
        pg8::gemm_phase<EpiZ, pg8::OrderSingle, PG8_ALIGN, PG8_SP2>(F.lds + RING_OFF, D, S, E);
        if (BOTH(1)) GRID_BAR(1);
    }

    if (IN(2)) {
        constexpr int N_LOC = NB * NH * (NSUP - 1), N_PS = MS / 64, N_DEC = DB * NH, N_ALL = N_LOC + N_PS + N_DEC;
        for (int w = blockIdx.x; w < N_ALL; w += F.G) {
            if (w >= N_LOC && w < N_LOC + N_PS) pool_item(F, MP / 64 + (w - N_LOC));
            else if (w < N_LOC) {
                const int seq = w / (NSUP - 1), j = w % (NSUP - 1), b = seq >> 2, h = seq & 3;
                HgrnItem it; it.m0 = b * T + j * (CH * SCH); it.nchunks = SCH; it.h = h; it.s_start = nullptr; it.s_out = nullptr;
                it.u_out = F.UWS + (size_t)(seq * NSUP + j) * UWS_ITEM; it.d_out = F.DTOT + (size_t)(seq * NSUP + j) * 128; it.pub = F.ctl + CW_CNTS + 64 * seq;
                hgrn_pipe<false>(F, it);
            }
        }
        {
            constexpr int NB0 = N_LOC + N_PS;
            int d = (int)blockIdx.x; while (d < NB0) d += F.G; d -= NB0;
            for (; d < N_DEC; d += 2 * F.G) { if (d + F.G < N_DEC) decode_items<2>(F, d, d + F.G); else decode_items<1>(F, d, d); }
        }
        for (int sidx = blockIdx.x; sidx < NB * NH * 8; sidx += F.G) {
            const int seq = sidx >> 3, f = (sidx & 7) * 512 + F.tid, dtq = 16 * ((f >> 8) & 7) + 4 * ((f >> 4) & 3);
            if (F.wave == 0) { unsigned sp = 0;
                while ((unsigned)__builtin_amdgcn_readfirstlane(__hip_atomic_load(F.ctl + CW_CNTS + 64 * seq, RLX_AGENT)) < (unsigned)((NSUP - 1) * NWAVES)) { __builtin_amdgcn_s_sleep(2); if (++sp > (1u << 22)) break; }
                __builtin_amdgcn_fence(__ATOMIC_ACQUIRE, "agent"); asm volatile("s_waitcnt vmcnt(0)" ::: "memory"); }
            __syncthreads();
            f32x4 u[NSUP - 1], dd[NSUP - 1];
#pragma unroll
            for (int j = 0; j < NSUP - 1; ++j) { u[j] = *(const f32x4*)(F.UWS + (size_t)(seq * NSUP + j) * UWS_ITEM + (size_t)f * 4); dd[j] = *(const f32x4*)(F.DTOT + (size_t)(seq * NSUP + j) * 128 + dtq); }
            f32x4 S = (f32x4){0.f, 0.f, 0.f, 0.f};
#pragma unroll
            for (int j = 0; j < NSUP - 1; ++j) { S = dd[j] * S + u[j]; *(f32x4*)(F.UWS + (size_t)(seq * NSUP + j + 1) * UWS_ITEM + (size_t)f * 4) = S; }
        }
        {
            const int ln = (((int)blockIdx.x >> 3) & 31) * 32 + (F.tid & 31);
            if (F.tid < 32) { const unsigned v = *(const volatile unsigned*)((const char*)F.WpT + (size_t)ln * 128); asm volatile("" :: "v"(v)); }
        }
        __syncthreads();
        if (BOTH(2)) GRID_BAR(2);
    }


    if (IN(4)) {
        for (int w = blockIdx.x; w < MP / 64; w += F.G) pool_item(F, w);
        for (int w = blockIdx.x; w < NB * NH * NSUP; w += F.G) {
            const int seq = w >> 3, j = w & 7, b = seq >> 2, h = seq & 3;
            HgrnItem it; it.m0 = b * T + j * (CH * SCH); it.nchunks = SCH; it.h = h; it.s_start = j ? F.UWS + (size_t)(seq * NSUP + j) * UWS_ITEM : nullptr;
            it.s_out = (j == NSUP - 1) ? F.out + O_SHP + (size_t)seq * DK * DV : nullptr; it.u_out = nullptr; it.d_out = nullptr; it.pub = nullptr;
            hgrn_pipe<true>(F, it);
        }
        __syncthreads();
        if (BOTH(4)) GRID_BAR(4);
    }

    if (IN(5)) {
        const int c = (int)blockIdx.x; const bool g256 = F.G == 256;
        const int vc = g256 ? ((c & 7) * 32 + (c >> 3)) : c;
        OrderTail S; S.init(M, D, F.G, c); S.OYp = (const char*)F.OY; S.Wab = (const char*)F.WabT; S.MGp = (const char*)F.MG; S.Wout = (const char*)F.WoutT; S.cnt1 = F.ctl + CW_CNT1;
        EpiTail E{F.MA, F.MB, F.MG, F.x_prompt, F.x_sample, F.final_norm_g, F.out, F.PART, F.ctl + CW_CNT2, F.lds};
        constexpr int NTILE = (M / 256) * (D / 256);
        S.kind2 = 0; S.t0 = vc; S.stride = F.G; S.xt = -1; S.xh = 0;
        if (g256) { S.count = 1; if (vc < 16) { S.xt = 256 + (vc >> 1); S.xh = vc & 1; } }
        else S.count = vc < NTILE ? (NTILE - 1 - vc) / F.G + 1 : 0;
        pg8::gemm_phase<EpiTail, OrderTail, PG8_ALIGN, PG8_SP2>(F.lds + RING_OFF, D, S, E);
        S.kind2 = 1; S.count = 1; S.xt = -1; S.xh = -1;
        if (g256) {
            S.t0 = vc < 8 ? 256 + vc : vc - 8; wait_panel(F.ctl + CW_CNT1, S.t0 >> 2, F.wave); pg8::gemm_phase<EpiTail, OrderTail, PG8_ALIGN, PG8_SP2>(F.lds + RING_OFF, D, S, E);
            if (vc >= 16 && vc < 32) { S.t0 = 248 + ((vc - 16) >> 1); S.xh = vc & 1; wait_panel(F.ctl + CW_CNT1, S.t0 >> 2, F.wave); pg8::gemm_phase<EpiTail, OrderTail, PG8_ALIGN, PG8_SP2>(F.lds + RING_OFF, D, S, E); }
        } else {
            for (int t = c; t < NTILE; t += F.G) { S.t0 = t; wait_panel(F.ctl + CW_CNT1, t >> 2, F.wave); pg8::gemm_phase<EpiTail, OrderTail, PG8_ALIGN, PG8_SP2>(F.lds + RING_OFF, D, S, E); }
        }
    }
#undef IN
#undef BOTH
}

extern "C" void kernel_launch(void* const* d_in, const int* in_sizes, int n_in, void* d_out, int out_size, void* d_ws, size_t ws_size, hipStream_t stream) {
    static int grid = 0;
    if (grid == 0) {
        if (n_in != 14 || in_sizes[0] != MP * D || out_size != (int)O_END || ws_size < WS_END) {
            fprintf(stderr, "kernel_launch: unexpected shapes (n_in %d, in0 %d, out %d, ws %zu need %zu); nothing launched\n", n_in, n_in > 0 ? in_sizes[0] : -1, out_size, ws_size, (size_t)WS_END); grid = -1; return; }
        int dev = 0, cus = 0, per_cu = 0;
        if (hipGetDevice(&dev) != hipSuccess || hipDeviceGetAttribute(&cus, hipDeviceAttributeMultiprocessorCount, dev) != hipSuccess) { grid = -1; return; }
        if (hipFuncSetAttribute((const void*)hgrn_pool_fwd, hipFuncAttributeMaxDynamicSharedMemorySize, LDS_BYTES) != hipSuccess) { fprintf(stderr, "kernel_launch: hipFuncSetAttribute failed\n"); grid = -1; return; }
        if (hipOccupancyMaxActiveBlocksPerMultiprocessor(&per_cu, (const void*)hgrn_pool_fwd, NWAVES * 64, LDS_BYTES) != hipSuccess || per_cu < 1) {
            fprintf(stderr, "kernel_launch: occupancy query reports %d workgroups per CU; nothing launched\n", per_cu); (void)hipGetLastError(); grid = -1; return; }
        grid = cus;
    }
    if (grid < 0) return;
    if (hipMemsetAsync((char*)d_ws + WS_CTL, 0, CTL_ZERO_BYTES, stream) != hipSuccess) return;
    Args a{};
    for (int i = 0; i < 14; ++i) a.in[i] = (const float*)d_in[i];
    a.out = (float*)d_out; a.ws = (unsigned char*)d_ws;
    for (int li = 0; li < N_LAUNCHES; ++li) {
        a.ph_lo = (N_LAUNCHES == PER_PHASE) ? li : 0; a.ph_hi = (N_LAUNCHES == PER_PHASE) ? li + 1 : PER_PHASE; a.li = li;
        hipLaunchKernelGGL(hgrn_pool_fwd, dim3(grid), dim3(NWAVES * 64), LDS_BYTES, stream, a);
        const hipError_t le = hipPeekAtLastError();
        if (le != hipSuccess) { fprintf(stderr, "kernel_launch: launch %d failed: %s\n", li, hipGetErrorName(le)); break; }
    }
}
```
